# Optimizing an MI355X kernel written in HIP

```python
import jax, jax.numpy as jnp
from jax import lax
import numpy as np

D_MODEL = 1024
BATCH = 1
SEQ = 16384
DEPTH = 1

HEAD_DIM = 64
SB_HEADS = 8
SB_WIDTH = SB_HEADS * HEAD_DIM
CONV_GROUPS = 4
CONV_WIDTH_CH = CONV_GROUPS * HEAD_DIM
MEM_HEADS = 4
MEM_WIDTH = MEM_HEADS * HEAD_DIM
MIX_WIDTH = SB_WIDTH + CONV_WIDTH_CH + MEM_WIDTH
N_MEM = 256
CONV_K = 3
SB_BLOCK = 128
EPS = 1e-6

SPLIT_POINTS = [
    SB_WIDTH,
    2 * SB_WIDTH,
    3 * SB_WIDTH,
    3 * SB_WIDTH + CONV_WIDTH_CH,
    3 * SB_WIDTH + 2 * CONV_WIDTH_CH,
    3 * SB_WIDTH + 3 * CONV_WIDTH_CH,
    3 * SB_WIDTH + 3 * CONV_WIDTH_CH + MEM_WIDTH,
]
PROJ_WIDTH = 3 * SB_WIDTH + 3 * CONV_WIDTH_CH + MEM_WIDTH + MIX_WIDTH

kernel_name = "hymba_sbattn_shortconv_memxattn"


def _rmsnorm(x, g):
    xf = x.astype(jnp.float32)
    y = xf * lax.rsqrt(jnp.mean(xf * xf, axis=-1, keepdims=True) + EPS)
    return (y * g.astype(jnp.float32)).astype(x.dtype)


def _stick_breaking_attention(q, k, v):
    b, t, h, dh = q.shape
    nblk = t // SB_BLOCK
    scale = dh ** -0.5
    key_pos = jnp.arange(t)
    q_blocks = q.reshape(b, nblk, SB_BLOCK, h, dh).transpose(1, 0, 2, 3, 4)
    starts = jnp.arange(nblk) * SB_BLOCK

    def block(args):
        q_blk, start = args
        q_pos = start + jnp.arange(SB_BLOCK)
        z = jnp.einsum('bqhd,bkhd->bhqk', q_blk, k,
                       preferred_element_type=jnp.float32) * scale
        before = key_pos[None, :] < q_pos[:, None]
        log_not = jnp.where(before, jax.nn.log_sigmoid(-z), 0.0)
        suffix = lax.cumsum(log_not, axis=3, reverse=True) - log_not
        w = jnp.where(before, jnp.exp(jax.nn.log_sigmoid(z) + suffix), 0.0)
        return jnp.einsum('bhqk,bkhd->bqhd', w.astype(v.dtype), v)

    out = lax.map(block, (q_blocks, starts))
    return out.transpose(1, 0, 2, 3, 4).reshape(b, t, h, dh)


def _causal_depthwise_conv(u, w, bias):
    c = u.shape[-1]
    y = lax.conv_general_dilated(
        u, w[:, None, :].astype(u.dtype), window_strides=(1,),
        padding=[(CONV_K - 1, 0)], dimension_numbers=('NWC', 'WIO', 'NWC'),
        feature_group_count=c)
    return y + bias.astype(u.dtype)


def _memory_attention(q, mk, mv):
    s = jnp.einsum('bthd,bmhd->bhtm', q, mk,
                   preferred_element_type=jnp.float32) * (q.shape[-1] ** -0.5)
    p = jax.nn.softmax(s, axis=-1)
    return jnp.einsum('bhtm,bmhd->bthd', p.astype(mv.dtype), mv)


def setup_inputs(seed: int = 0) -> dict:
    key = jax.random.key(seed)
    ks = jax.random.split(key, 14)
    f32 = jnp.float32
    x = jax.random.normal(ks[0], (BATCH, SEQ, D_MODEL), f32)
    mem = jax.random.normal(ks[1], (BATCH, N_MEM, D_MODEL), f32)
    g_in = 1.0 + 0.02 * jax.random.normal(ks[2], (DEPTH, D_MODEL), f32)
    w_in = jax.random.normal(ks[3], (DEPTH, D_MODEL, PROJ_WIDTH), f32) * D_MODEL ** -0.5
    conv_w = jax.random.normal(ks[4], (DEPTH, CONV_K, CONV_WIDTH_CH), f32) * CONV_K ** -0.5
    conv_b = 0.01 * jax.random.normal(ks[5], (DEPTH, CONV_WIDTH_CH), f32)
    g_mem = 1.0 + 0.02 * jax.random.normal(ks[6], (DEPTH, D_MODEL), f32)
    w_mem_kv = jax.random.normal(ks[7], (DEPTH, D_MODEL, 2 * MEM_WIDTH), f32) * D_MODEL ** -0.5
    g_sb_out = 1.0 + 0.02 * jax.random.normal(ks[8], (DEPTH, SB_WIDTH), f32)
    g_conv_out = 1.0 + 0.02 * jax.random.normal(ks[9], (DEPTH, CONV_WIDTH_CH), f32)
    g_mem_out = 1.0 + 0.02 * jax.random.normal(ks[10], (DEPTH, MEM_WIDTH), f32)
    w_out = jax.random.normal(ks[11], (DEPTH, MIX_WIDTH, D_MODEL), f32) * MIX_WIDTH ** -0.5
    g_final = 1.0 + 0.02 * jax.random.normal(ks[12], (D_MODEL,), f32)
    return {"x": x, "mem": mem, "g_in": g_in, "w_in": w_in, "conv_w": conv_w,
            "conv_b": conv_b, "g_mem": g_mem, "w_mem_kv": w_mem_kv,
            "g_sb_out": g_sb_out, "g_conv_out": g_conv_out, "g_mem_out": g_mem_out,
            "w_out": w_out, "g_final": g_final}


def reference(x, mem, g_in, w_in, conv_w, conv_b, g_mem, w_mem_kv,
              g_sb_out, g_conv_out, g_mem_out, w_out, g_final):
    b, t, _ = x.shape
    for l in range(DEPTH):
        h = _rmsnorm(x, g_in[l])
        proj = h @ w_in[l]
        q_sb, k_sb, v_sb, u_c, b_c, c_c, q_mem, gate = jnp.split(proj, SPLIT_POINTS, axis=-1)

        y_sb = _stick_breaking_attention(
            q_sb.reshape(b, t, SB_HEADS, HEAD_DIM),
            k_sb.reshape(b, t, SB_HEADS, HEAD_DIM),
            v_sb.reshape(b, t, SB_HEADS, HEAD_DIM)).reshape(b, t, SB_WIDTH)

        y_conv = b_c * _causal_depthwise_conv(c_c * u_c, conv_w[l], conv_b[l])

        m = _rmsnorm(mem, g_mem[l])
        mk, mv = jnp.split(m @ w_mem_kv[l], 2, axis=-1)
        nm = mem.shape[1]
        y_mem = _memory_attention(
            q_mem.reshape(b, t, MEM_HEADS, HEAD_DIM),
            mk.reshape(b, nm, MEM_HEADS, HEAD_DIM),
            mv.reshape(b, nm, MEM_HEADS, HEAD_DIM)).reshape(b, t, MEM_WIDTH)

        y = jnp.concatenate([_rmsnorm(y_sb, g_sb_out[l]),
                             _rmsnorm(y_conv, g_conv_out[l]),
                             _rmsnorm(y_mem, g_mem_out[l])], axis=-1)
        x = x + (y * jax.nn.silu(gate)) @ w_out[l]
    return _rmsnorm(x, g_final)
```

```cpp
#include <hip/hip_runtime.h>
#include <hip/hip_cooperative_groups.h>
#include <cstdio>
namespace cg = cooperative_groups;

#ifndef COOP
#define COOP 1
#endif
#ifndef PROBE_DUP
#define PROBE_DUP -1
#endif

#define LAS __attribute__((address_space(3)))
typedef unsigned short bf16_t;
typedef short bf16x8 __attribute__((ext_vector_type(8)));
typedef short s16x4 __attribute__((ext_vector_type(4)));
typedef float f32x4 __attribute__((ext_vector_type(4)));
typedef float f32x2 __attribute__((ext_vector_type(2)));
typedef float f32x16 __attribute__((ext_vector_type(16)));
typedef unsigned u32x4 __attribute__((ext_vector_type(4)));
typedef unsigned u32x2 __attribute__((ext_vector_type(2)));
typedef __bf16 bf2_t __attribute__((ext_vector_type(2)));
#define DI __device__ __forceinline__

constexpr int T = 16384, D = 1024, PROJ = 3584, NMEM = 256;
constexpr float EPS = 1e-6f;
constexpr float QSCALE = 0.125f * 1.4426950408889634f;
constexpr float SB_STOP_F = 0x1p-48f;
constexpr int XCD_BAR_WORDS_C = 3456;
constexpr int LDS_MAIN = 4096 + 64 * 2048;

constexpr size_t OPS_ROWS = 16384 + 256 + 3584 + 512;
constexpr size_t WS_OPS = 0;
constexpr size_t WS_WOUT = WS_OPS + OPS_ROWS * 2048;
constexpr size_t WS_QK = WS_WOUT + (size_t)1024 * 2048;
constexpr size_t WS_VT = WS_QK + (size_t)T * 2048;
constexpr size_t WS_R = WS_VT + (size_t)512 * T * 2;
constexpr size_t WS_MK = WS_R + (size_t)T * 4096;
constexpr size_t WS_MVT = WS_MK + (size_t)256 * 512;
constexpr size_t WS_Y = WS_OPS;
constexpr size_t WS_SSQ = WS_MVT + (size_t)256 * 512;
constexpr size_t WS_BAR = WS_SSQ + (size_t)4 * T * 4;
constexpr size_t WS_PCNT = WS_BAR + (size_t)XCD_BAR_WORDS_C * 4;
constexpr size_t WS_END = WS_PCNT + (size_t)64 * 256;

struct Params {
    const float *x, *mem, *g_in, *w_in, *conv_w, *conv_b, *g_mem, *w_kv, *g_sb, *g_conv, *g_memo, *w_out, *g_final;
    float* out;
    unsigned char* ws;
};

DI unsigned pk_bf16(float lo, float hi) { f32x2 v = {lo, hi}; bf2_t b = __builtin_convertvector(v, bf2_t); return __builtin_bit_cast(unsigned, b); }
DI float bf_lo(unsigned u) { return __uint_as_float(u << 16); }
DI float bf_hi(unsigned u) { return __uint_as_float(u & 0xffff0000u); }
DI float wave_sum(float v) { v += __shfl_xor(v, 32); v += __shfl_xor(v, 16); v += __shfl_xor(v, 8); v += __shfl_xor(v, 4); v += __shfl_xor(v, 2); v += __shfl_xor(v, 1); return v; }
DI float silu(float x) { return x * __builtin_amdgcn_rcpf(1.0f + __builtin_amdgcn_exp2f(-1.4426950408889634f * x)); }
#define MFMA32(a, b, c) __builtin_amdgcn_mfma_f32_32x32x16_bf16((a), (b), (c), 0, 0, 0)

#define XB_TMO      128
#define XB_XCNT(j)  (256  + 64 * (j))
#define XB_XSUB(j)  (1280 + 64 * (j))
#define XB_XGEN(j)  (2304 + 64 * (j))
#define XB_TOP      3328
#define XB_TOPGEN   3392
#define XCD_BAR_WORDS 3456
#define XB_SPIN_CAP (1u << 18)
DI unsigned xb_ld(unsigned* p)              { return __hip_atomic_load(p, __ATOMIC_RELAXED, __HIP_MEMORY_SCOPE_AGENT); }
DI unsigned xb_add(unsigned* p, unsigned v) { return __hip_atomic_fetch_add(p, v, __ATOMIC_RELAXED, __HIP_MEMORY_SCOPE_AGENT); }
DI unsigned xb_xcc_id() { return (unsigned)__builtin_amdgcn_s_getreg((3 << 11) | 20) & 0xFu; }
#define XB_SPIN(cond, bar) do { unsigned _sp = 0; while (cond) { __builtin_amdgcn_s_sleep(1); \
    if ((++_sp & 255u) == 0u) { if (xb_ld(&(bar)[XB_TMO])) break; if (_sp > XB_SPIN_CAP) { atomicAdd(&(bar)[XB_TMO], 1u); break; } } } } while (0)
struct XcdBarrier { unsigned* bar; unsigned x; volatile LAS unsigned* st; };
DI XcdBarrier xcd_barrier_post(unsigned* bar, volatile LAS unsigned* st) {
    XcdBarrier b; b.bar = bar; b.x = xb_xcc_id(); b.st = st;
    if (threadIdx.x == 0) (void)xb_add(&bar[XB_XCNT(b.x)], 1u);
    return b;
}
DI void xcd_barrier_complete(unsigned* bar, unsigned x, unsigned& nloc, unsigned& nx) {
    const unsigned G = gridDim.x * gridDim.y * gridDim.z;
    unsigned sum, cnt, mine, sp = 0u;
    for (;;) {
        sum = 0u; cnt = 0u; mine = 0u;
#pragma unroll
        for (unsigned j = 0; j < 16; ++j) { const unsigned c = xb_ld(&bar[XB_XCNT(j)]); sum += c; cnt += (c > 0u) ? 1u : 0u; mine = (j == x) ? c : mine; }
        if (sum == G) break;
        __builtin_amdgcn_s_sleep(1);
        if ((++sp & 255u) == 0u) { if (xb_ld(&bar[XB_TMO])) break; if (sp > XB_SPIN_CAP) { atomicAdd(&bar[XB_TMO], 1u); break; } }
    }
    nloc = mine > 0u ? mine : 1u; nx = cnt > 0u ? cnt : 1u;
}
struct NoHook { DI void operator()() const {} };
template <class Hook = NoHook> DI void xcd_barrier(const XcdBarrier& b, const Hook& hook = Hook()) {
    asm volatile("s_waitcnt vmcnt(0)" ::: "memory");
    __syncthreads();
    if (threadIdx.x >= 64) hook();
    if (threadIdx.x == 0) {
        unsigned* bar = b.bar;
        __builtin_amdgcn_s_waitcnt(0);
        unsigned nloc = b.st[0], nx = b.st[1];
        if (nloc == 0u) { xcd_barrier_complete(bar, b.x, nloc, nx); b.st[0] = nloc; b.st[1] = nx; }
        const unsigned old = xb_add(&bar[XB_XSUB(b.x)], 1u);
        const unsigned gen = old / nloc;
        if (old + 1u == (gen + 1u) * nloc) {
            __builtin_amdgcn_fence(__ATOMIC_RELEASE, "agent");
            asm volatile("s_waitcnt vmcnt(0)" ::: "memory");
            const unsigned og = xb_add(&bar[XB_TOP], 1u);
            const unsigned tg = og / nx;
            if (og + 1u == (tg + 1u) * nx) xb_add(&bar[XB_TOPGEN], 1u);
            else XB_SPIN(xb_ld(&bar[XB_TOPGEN]) == tg, bar);
            __builtin_amdgcn_fence(__ATOMIC_ACQUIRE, "agent");
            xb_add(&bar[XB_XGEN(b.x)], 1u);
            asm volatile("s_waitcnt vmcnt(0)" ::: "memory");
        } else {
            XB_SPIN(xb_ld(&bar[XB_XGEN(b.x)]) == gen, bar);
            __builtin_amdgcn_fence(__ATOMIC_ACQUIRE, "agent");
            asm volatile("s_waitcnt vmcnt(0)" ::: "memory");
        }
    }
    __syncthreads();
    if (threadIdx.x < 64) hook();
}

DI void prep_row(const f32x4 (&v)[4], const f32x4 (&gg)[4], bf16_t* dst, int lane) {
    float ss = 0.f;
#pragma unroll
    for (int j = 0; j < 4; ++j) ss += (v[j][0] * v[j][0] + v[j][1] * v[j][1]) + (v[j][2] * v[j][2] + v[j][3] * v[j][3]);
    ss = wave_sum(ss);
    const float rs = rsqrtf(ss * (1.0f / 1024.0f) + EPS);
#pragma unroll
    for (int j = 0; j < 4; ++j) {
        u32x2 w; w.x = pk_bf16(v[j][0] * rs * gg[j][0], v[j][1] * rs * gg[j][1]); w.y = pk_bf16(v[j][2] * rs * gg[j][2], v[j][3] * rs * gg[j][3]);
        *(u32x2*)(dst + 256 * j + 4 * lane) = w; }
}
DI void prep_phase(const Params& p, unsigned char* lds) {
    int tid = threadIdx.x; asm volatile("" : "+v"(tid));
    const int wid = tid >> 6, lane = tid & 63;
    bf16_t* ops = (bf16_t*)(p.ws + WS_OPS);
    float* tile = (float*)lds;
    for (int si = blockIdx.x; si < 256; si += gridDim.x) {
        const int kt = si >> 4, ns = si & 15;
        const int row = tid >> 3, c = (tid & 7) * 8;
        f32x4 la[5], lb[5];
#pragma unroll
        for (int j = 0; j < 5; ++j) { const int ti = ns * 5 + j; const float* src; int N, nt;
            if (ti < 56) { src = p.w_in; N = PROJ; nt = ti; } else if (ti < 72) { src = p.w_out; N = 1024; nt = ti - 56; } else { src = p.w_kv; N = 512; nt = ti - 72; }
            const float* sp = src + (size_t)(kt * 64 + row) * N + nt * 64 + c; la[j] = *(const f32x4*)sp; lb[j] = *(const f32x4*)(sp + 4); }
#pragma unroll
        for (int j = 0; j < 5; ++j) { float* tp = tile + j * (64 * 65) + row * 65 + c;
#pragma unroll
            for (int i = 0; i < 4; ++i) { tp[i] = la[j][i]; tp[4 + i] = lb[j][i]; } }
        __syncthreads();
        const int n = tid >> 3, kc = (tid & 7) * 8;
#pragma unroll
        for (int j = 0; j < 5; ++j) { const int ti = ns * 5 + j; bf16_t* dst; int nt;
            if (ti < 56) { dst = ops + (size_t)16640 * 1024; nt = ti; } else if (ti < 72) { dst = (bf16_t*)(p.ws + WS_WOUT); nt = ti - 56; } else { dst = ops + (size_t)20224 * 1024; nt = ti - 72; }
            const float* tp = tile + j * (64 * 65) + n; float v[8];
#pragma unroll
            for (int i = 0; i < 8; ++i) v[i] = tp[(kc + i) * 65];
            u32x4 w; w.x = pk_bf16(v[0], v[1]); w.y = pk_bf16(v[2], v[3]); w.z = pk_bf16(v[4], v[5]); w.w = pk_bf16(v[6], v[7]);
            *(u32x4*)(dst + (size_t)(nt * 64 + n) * 1024 + kt * 64 + kc) = w; }
        __syncthreads();
    }
    const int nw = gridDim.x * 8, gw = blockIdx.x * 8 + wid;
    {
        f32x4 gg[4];
#pragma unroll
        for (int j = 0; j < 4; ++j) gg[j] = *(const f32x4*)(p.g_in + 256 * j + 4 * lane);
        for (int row = gw; row < T; row += 2 * nw) {
            const int rowB = row + nw; const bool hasB = rowB < T; const int rb = hasB ? rowB : row;
            const float* srcA = p.x + (size_t)row * D; const float* srcB = p.x + (size_t)rb * D;
            f32x4 va[4], vb[4];
#pragma unroll
            for (int j = 0; j < 4; ++j) va[j] = *(const f32x4*)(srcA + 256 * j + 4 * lane);
#pragma unroll
            for (int j = 0; j < 4; ++j) vb[j] = *(const f32x4*)(srcB + 256 * j + 4 * lane);
            __builtin_amdgcn_sched_barrier(0);
            prep_row(va, gg, ops + (size_t)row * 1024, lane);
            if (hasB) prep_row(vb, gg, ops + (size_t)rb * 1024, lane);
        }
    }
    if (gw < NMEM) {
        f32x4 gg[4], va[4];
#pragma unroll
        for (int j = 0; j < 4; ++j) { gg[j] = *(const f32x4*)(p.g_mem + 256 * j + 4 * lane); va[j] = *(const f32x4*)(p.mem + (size_t)gw * D + 256 * j + 4 * lane); }
        prep_row(va, gg, ops + (size_t)(T + gw) * 1024, lane);
    }
}

namespace pg8 {
constexpr int BM = 256, BK = 64, HALF = 128, HTB = HALF * BK * 2, STAGE_BYTES = 8 * HTB, NXCD = 8, WGM = 8;
DI int lds_byte(int r, int c) { const int st = (r >> 4) * 2 + (c >> 5), rr = r & 15, cc = c & 31, ob = rr * 64 + cc * 2; return st * 1024 + (ob ^ (((ob >> 9) & 1) << 5)); }
DI void stage_rc(int b, int& R, int& C) { const int st = b / 1024, sb = b % 1024, swz = sb ^ (((sb >> 9) & 1) << 5); R = (st >> 1) * 16 + swz / 64; C = (st & 1) * 32 + (swz % 64) / 2; }
DI int perm32(int rho) { const int n = rho >> 4, i = rho & 15; return 8 * (i >> 2) + 4 * n + (i & 3); }

struct Unit { int pm, pn, kind, om, on; };
struct Gemm { const bf16_t* A; const bf16_t* Bt; int K; };

struct ProjOrder {
    int G, c;
    DI bool next(int i, Unit& u) const {
        const int L = i * G + c;
        if (L >= 898) return false;
        if (L == 896) { u.pm = 64; u.pn = 79; u.kind = 3; u.om = 0; u.on = 0; return true; }
        if (L == 897) { u.pm = 80; u.pn = 64; u.kind = 4; u.om = 0; u.on = 0; return true; }
        const int xcd = L & 7, off = L >> 3, wgid = xcd * 112 + off;
        const int vpm = xcd * 8 + ((wgid % 112) & 7), vpn = (wgid % 112) >> 3;
        if (vpn < 4) { u.pm = vpm; u.pn = 65 + vpn; u.kind = 0; u.om = vpm; u.on = vpn; }
        else if (vpn < 6) { u.pm = 65 + vpn; u.pn = vpm; u.kind = 1; u.om = vpn - 4; u.on = vpm; }
        else { u.pm = vpm; u.pn = 65 + vpn; u.kind = 2; u.om = vpm; u.on = vpn - 6; }
        return true;
    }
};
struct OutOrder {
    int G, c;
    DI bool next(int i, Unit& u) const {
        const int L = i * G + c;
        if (L >= 256) return false;
        const int xcd = L & 7, off = L >> 3;
        u.pm = xcd * 8 + (off & 7); u.pn = off >> 3; u.kind = 0; u.om = u.pm; u.on = u.pn; return true;
    }
};

struct EpiProj {
    static constexpr bool PERM = true, AFTER_DRAIN = false;
    bf16_t *qk, *vt, *r, *mk, *mvt;
    DI void operator()(const f32x4 (&acc)[2][2][4][2], const Unit& u, int wr, int wc, int fr, int fq) const {
        bf16_t* base; int ldc; float sc = 1.0f;
        if (u.kind == 0) { base = qk; ldc = 1024; if (u.on < 2) sc = QSCALE; }
        else if (u.kind == 1) { base = vt; ldc = T; }
        else if (u.kind == 2) { base = r; ldc = 2048; if (u.on == 3) sc = QSCALE; }
        else if (u.kind == 3) { base = mk; ldc = 256; }
        else { base = mvt; ldc = 256; }
        const int row0 = u.om * BM + wr * 64 + fr, col0 = u.on * BM + wc * 32 + 8 * fq;
#pragma unroll
        for (int ai = 0; ai < 2; ++ai)
#pragma unroll
            for (int m = 0; m < 4; ++m) { bf16_t* rowp = base + (size_t)(row0 + ai * HALF + m * 16) * ldc + col0;
#pragma unroll
                for (int bj = 0; bj < 2; ++bj) { const f32x4 v0 = acc[ai][bj][m][0] * sc, v1 = acc[ai][bj][m][1] * sc;
                    u32x4 w; w.x = pk_bf16(v0[0], v0[1]); w.y = pk_bf16(v0[2], v0[3]); w.z = pk_bf16(v1[0], v1[1]); w.w = pk_bf16(v1[2], v1[3]);
                    *(u32x4*)(rowp + bj * HALF) = w; } }
    }
};

template <bool FUSE_SYNC> struct EpiFinal {
    static constexpr bool PERM = false, AFTER_DRAIN = true;
    const float* x; const float* gf; float* out; float* ssq; XcdBarrier xb; unsigned* pcnt;
    DI void load_x(f32x4 (&acc)[2][2][4][2], const Unit& u, int tid) const {
        const int wid = tid >> 6, lane = tid & 63, wr = wid >> 2, wc = wid & 3, fr = lane & 15, fq = lane >> 4;
        const int row0 = u.pm * BM + wr * 64 + fr, col0 = u.pn * BM + wc * 32 + 4 * fq;
#pragma unroll
        for (int ai = 0; ai < 2; ++ai)
#pragma unroll
            for (int m = 0; m < 4; ++m) { const float* xr = x + (size_t)(row0 + ai * HALF + m * 16) * D + col0;
#pragma unroll
                for (int bj = 0; bj < 2; ++bj)
#pragma unroll
                    for (int n = 0; n < 2; ++n) acc[ai][bj][m][n] = *(const f32x4*)(xr + bj * HALF + n * 16); }
    }
    DI void fused(f32x4 (&acc)[2][2][4][2], const Unit& u, int wr, int wc, int fr, int fq, LAS unsigned char* lds, int wid, int lane) const {
        LAS float* P = (LAS float*)lds;
        const int row0 = u.pm * BM + wr * 64 + fr, col0 = u.pn * BM + wc * 32 + 4 * fq;
#pragma unroll
        for (int ai = 0; ai < 2; ++ai)
#pragma unroll
            for (int m = 0; m < 4; ++m) { float s = 0.f;
#pragma unroll
                for (int bj = 0; bj < 2; ++bj)
#pragma unroll
                    for (int n = 0; n < 2; ++n) { const f32x4 a = acc[ai][bj][m][n]; s += (a[0] * a[0] + a[1] * a[1]) + (a[2] * a[2] + a[3] * a[3]); }
                s += __shfl_xor(s, 16); s += __shfl_xor(s, 32);
                if (fq == 0) P[(ai * HALF + wr * 64 + m * 16 + fr) * 4 + wc] = s; }
        __syncthreads();
        if constexpr (!FUSE_SYNC) { if (wid * 64 + lane < 256) { const int rr = wid * 64 + lane; const float s = (P[rr * 4 + 0] + P[rr * 4 + 1]) + (P[rr * 4 + 2] + P[rr * 4 + 3]); ssq[(size_t)u.pn * T + u.pm * BM + rr] = s; } }
        if constexpr (FUSE_SYNC) {
            unsigned* slots = (unsigned*)ssq; unsigned* cnt = pcnt + 64 * u.pm;
            if (wid < 4) { const int rr = wid * 64 + lane; const float s = (P[rr * 4 + 0] + P[rr * 4 + 1]) + (P[rr * 4 + 2] + P[rr * 4 + 3]);
                __hip_atomic_store(slots + (size_t)u.pn * T + u.pm * BM + rr, __float_as_uint(s), __ATOMIC_RELAXED, __HIP_MEMORY_SCOPE_AGENT);
                asm volatile("s_waitcnt vmcnt(0)" ::: "memory");
                if (lane == 0) __hip_atomic_fetch_add(cnt, 1u, __ATOMIC_RELAXED, __HIP_MEMORY_SCOPE_AGENT); }
            if (wid == 0) {
                unsigned polls = 0;
                while ((unsigned)__builtin_amdgcn_readfirstlane(__hip_atomic_load(cnt, __ATOMIC_RELAXED, __HIP_MEMORY_SCOPE_AGENT)) < 16u) { if (++polls > (1u << 20)) break; __builtin_amdgcn_s_sleep(1); }
                __builtin_amdgcn_fence(__ATOMIC_ACQUIRE, "agent");
            }
            asm volatile("s_waitcnt vmcnt(0) lgkmcnt(0)" ::: "memory"); __builtin_amdgcn_s_barrier(); asm volatile("" ::: "memory");
            float rs[2][4]; f32x4 gv[2][2];
            if (wid < 4) {
                const int rr = wid * 64 + lane; const unsigned* sp = slots + u.pm * BM + rr;
                const float tot = (__uint_as_float(__hip_atomic_load(sp, __ATOMIC_RELAXED, __HIP_MEMORY_SCOPE_AGENT)) + __uint_as_float(__hip_atomic_load(sp + T, __ATOMIC_RELAXED, __HIP_MEMORY_SCOPE_AGENT)))
                                + (__uint_as_float(__hip_atomic_load(sp + 2 * T, __ATOMIC_RELAXED, __HIP_MEMORY_SCOPE_AGENT)) + __uint_as_float(__hip_atomic_load(sp + 3 * T, __ATOMIC_RELAXED, __HIP_MEMORY_SCOPE_AGENT)));
                P[rr] = rsqrtf(tot * (1.0f / 1024.0f) + EPS); }
            __syncthreads();
#pragma unroll
            for (int ai = 0; ai < 2; ++ai)
#pragma unroll
                for (int m = 0; m < 4; ++m) rs[ai][m] = P[ai * HALF + wr * 64 + m * 16 + fr];
#pragma unroll
            for (int bj = 0; bj < 2; ++bj)
#pragma unroll
                for (int n = 0; n < 2; ++n) gv[bj][n] = *(const f32x4*)(gf + col0 + bj * HALF + n * 16);
#pragma unroll
            for (int ai = 0; ai < 2; ++ai)
#pragma unroll
                for (int m = 0; m < 4; ++m) { float* orow = out + (size_t)(row0 + ai * HALF + m * 16) * D + col0;
#pragma unroll
                    for (int bj = 0; bj < 2; ++bj)
#pragma unroll
                        for (int n = 0; n < 2; ++n) *(f32x4*)(orow + bj * HALF + n * 16) = acc[ai][bj][m][n] * rs[ai][m] * gv[bj][n]; }
        } else {
#pragma unroll
            for (int ai = 0; ai < 2; ++ai)
#pragma unroll
                for (int m = 0; m < 4; ++m) { float* orow = out + (size_t)(row0 + ai * HALF + m * 16) * D + col0;
#pragma unroll
                    for (int bj = 0; bj < 2; ++bj)
#pragma unroll
                        for (int n = 0; n < 2; ++n) *(f32x4*)(orow + bj * HALF + n * 16) = acc[ai][bj][m][n]; }
        }
    }
    DI void operator()(const f32x4 (&)[2][2][4][2], const Unit&, int, int, int, int) const {}
};

template <class Epi, class Sched, bool ALIGN_EPI = false, bool SP2 = true>
DI void gemm_phase(LAS unsigned char* lds, const Gemm g, const Sched& S, const Epi& E, f32x4 (&acc)[2][2][4][2]) {
    int tid = threadIdx.x; asm volatile("" : "+v"(tid));
    const int wid = __builtin_amdgcn_readfirstlane(tid >> 6), lane = tid & 63, wr = wid >> 2, wc = wid & 3, fr = lane & 15, fq = lane >> 4;
    const int K = g.K, nt = K / BK;
    unsigned voffA[2], voffB[2];
#pragma unroll
    for (int i = 0; i < 2; ++i) { int R, C; stage_rc(tid * 16 + i * 8192, R, C); const int Rb = Epi::PERM ? ((R & ~31) + perm32(R & 31)) : R;
        voffA[i] = (unsigned)(R * K + C) * 2u; voffB[i] = (unsigned)(Rb * K + C) * 2u; }
    const size_t kstep = (size_t)(BK * 2);
    const size_t hstep = (size_t)HALF * K * 2;
    const size_t tstep = 2 * hstep;
    const unsigned ldsw = (unsigned)wid * 1024u;
    const int aoff = lds_byte(wr * 64 + fr, fq * 8), boff = lds_byte(wc * 32 + fr, fq * 8);
#define PG8_SA(b, h) (((b) * 2 + (h)) * HTB)
#define PG8_SB(b, h) ((4 + (b) * 2 + (h)) * HTB)
#define PG8_STAGE(bufoff, gbase, voff) do { _Pragma("unroll") for (int _i = 0; _i < 2; ++_i) \
        __builtin_amdgcn_global_load_lds((const unsigned*)((const char*)(gbase) + (voff)[_i]), (LAS unsigned*)(lds + (bufoff) + ldsw + _i * 8192), 16, 0, 0); } while (0)
#define PG8_LDA(dst, b, h) do { _Pragma("unroll") for (int m = 0; m < 4; ++m) _Pragma("unroll") for (int k = 0; k < 2; ++k) dst[m][k] = *(const LAS bf16x8*)(lds + PG8_SA(b, h) + aoff + m * 2048 + k * 1024); } while (0)
#define PG8_LDB(dst, b, h) do { _Pragma("unroll") for (int n = 0; n < 2; ++n) _Pragma("unroll") for (int k = 0; k < 2; ++k) dst[n][k] = *(const LAS bf16x8*)(lds + PG8_SB(b, h) + boff + n * 2048 + k * 1024); } while (0)
#define PG8_MMA(ai, bj, At, Bt) do { __builtin_amdgcn_s_setprio(1); _Pragma("unroll") for (int m = 0; m < 4; ++m) _Pragma("unroll") for (int n = 0; n < 2; ++n) _Pragma("unroll") for (int k = 0; k < 2; ++k) \
        acc[ai][bj][m][n] = __builtin_amdgcn_mfma_f32_16x16x32_bf16(Bt[n][k], At[m][k], acc[ai][bj][m][n], 0, 0, 0); __builtin_amdgcn_s_setprio(0); } while (0)
#define PG8_WAIT_V(n) asm volatile("s_waitcnt vmcnt(" #n ")" ::: "memory")
#define PG8_WAIT_L(n) asm volatile("s_waitcnt lgkmcnt(" #n ")" ::: "memory")
#define PG8_BAR __builtin_amdgcn_s_barrier()
#define PG8_SCHED __builtin_amdgcn_sched_barrier(0)
    Unit cur, nxt; int ui = 0;
    if (!S.next(0, cur)) return;
    bf16x8 At[4][2], B0[2][2], B1[2][2];
    const char* cA = (const char*)g.A + (size_t)cur.pm * tstep; const char* cB = (const char*)g.Bt + (size_t)cur.pn * tstep;
    if constexpr (SP2) {
        PG8_STAGE(PG8_SB(0, 0), cB, voffB); PG8_STAGE(PG8_SB(0, 1), cB + hstep, voffB); PG8_STAGE(PG8_SA(0, 0), cA, voffA); PG8_STAGE(PG8_SA(0, 1), cA + hstep, voffA);
        if (wr == 1) PG8_BAR;
        PG8_WAIT_V(2); PG8_BAR;
        PG8_STAGE(PG8_SB(1, 0), cB + kstep, voffB); PG8_STAGE(PG8_SA(1, 0), cA + kstep, voffA); PG8_STAGE(PG8_SB(1, 1), cB + hstep + kstep, voffB);
        PG8_WAIT_V(6); PG8_BAR;
    } else {
        PG8_STAGE(PG8_SB(0, 0), cB, voffB); PG8_STAGE(PG8_SA(0, 0), cA, voffA); PG8_STAGE(PG8_SB(0, 1), cB + hstep, voffB); PG8_STAGE(PG8_SA(0, 1), cA + hstep, voffA);
        if (wr == 1) PG8_BAR;
        PG8_WAIT_V(4); PG8_BAR;
        PG8_STAGE(PG8_SB(1, 0), cB + kstep, voffB); PG8_STAGE(PG8_SA(1, 0), cA + kstep, voffA); PG8_STAGE(PG8_SB(1, 1), cB + hstep + kstep, voffB);
        PG8_WAIT_V(6); PG8_BAR;
    }
    for (;;) {
        const bool has_next = S.next(ui + 1, nxt);
        const char* nA = has_next ? (const char*)g.A + (size_t)nxt.pm * tstep : cA; const char* nB = has_next ? (const char*)g.Bt + (size_t)nxt.pn * tstep : cB;
        for (int t = 0; t < nt; t += 2) {
            const bool last = (t == nt - 2);
            const char* a1 = cA + (size_t)(t + 1) * kstep;
            const char* a2 = last ? nA : cA + (size_t)(t + 2) * kstep; const char* b2 = last ? nB : cB + (size_t)(t + 2) * kstep;
            const char* a3 = a2 + kstep; const char* b3 = b2 + kstep;
            if constexpr (SP2) {
            PG8_LDB(B0, 0, 0); PG8_LDB(B1, 0, 1); PG8_SCHED; PG8_LDA(At, 0, 0); PG8_STAGE(PG8_SA(1, 1), a1 + hstep, voffA);
            PG8_WAIT_V(8); PG8_WAIT_L(0); PG8_BAR; PG8_MMA(0, 0, At, B0); PG8_MMA(0, 1, At, B1); PG8_BAR; PG8_SCHED;
            PG8_LDA(At, 0, 1); PG8_STAGE(PG8_SB(0, 0), b2, voffB); PG8_STAGE(PG8_SB(0, 1), b2 + hstep, voffB); PG8_STAGE(PG8_SA(0, 0), a2, voffA);
            PG8_WAIT_V(8); PG8_WAIT_L(0); PG8_BAR; PG8_MMA(1, 0, At, B0); PG8_MMA(1, 1, At, B1); PG8_BAR; PG8_SCHED;
            PG8_LDB(B0, 1, 0); PG8_LDB(B1, 1, 1); PG8_SCHED; PG8_LDA(At, 1, 0); PG8_STAGE(PG8_SA(0, 1), a2 + hstep, voffA);
            PG8_WAIT_V(8); PG8_WAIT_L(0); PG8_BAR; PG8_MMA(0, 0, At, B0); PG8_MMA(0, 1, At, B1); PG8_BAR; PG8_SCHED;
            PG8_LDA(At, 1, 1); PG8_STAGE(PG8_SB(1, 0), b3, voffB); PG8_STAGE(PG8_SB(1, 1), b3 + hstep, voffB); PG8_STAGE(PG8_SA(1, 0), a3, voffA);
            PG8_WAIT_V(8); PG8_WAIT_L(0); PG8_BAR; PG8_MMA(1, 0, At, B0); PG8_MMA(1, 1, At, B1); PG8_BAR; PG8_SCHED;
            } else {
            PG8_LDB(B0, 0, 0); PG8_SCHED; PG8_LDA(At, 0, 0); PG8_STAGE(PG8_SA(1, 1), a1 + hstep, voffA);
            PG8_WAIT_L(8); PG8_BAR; PG8_WAIT_L(0); PG8_MMA(0, 0, At, B0); PG8_BAR; PG8_SCHED;
            PG8_LDB(B1, 0, 1); PG8_STAGE(PG8_SB(0, 0), b2, voffB);
            PG8_BAR; PG8_WAIT_L(0); PG8_MMA(0, 1, At, B1); PG8_BAR;
            PG8_LDA(At, 0, 1); PG8_STAGE(PG8_SA(0, 0), a2, voffA);
            PG8_BAR; PG8_WAIT_L(0); PG8_MMA(1, 0, At, B0); PG8_BAR; PG8_SCHED;
            PG8_STAGE(PG8_SB(0, 1), b2 + hstep, voffB);
            PG8_WAIT_V(6); PG8_BAR; PG8_MMA(1, 1, At, B1); PG8_BAR;
            PG8_LDB(B0, 1, 0); PG8_SCHED; PG8_LDA(At, 1, 0); PG8_STAGE(PG8_SA(0, 1), a2 + hstep, voffA);
            PG8_WAIT_L(8); PG8_BAR; PG8_WAIT_L(0); PG8_MMA(0, 0, At, B0); PG8_BAR; PG8_SCHED;
            PG8_LDB(B1, 1, 1); PG8_STAGE(PG8_SB(1, 0), b3, voffB);
            PG8_BAR; PG8_WAIT_L(0); PG8_MMA(0, 1, At, B1); PG8_BAR;
            PG8_LDA(At, 1, 1); PG8_STAGE(PG8_SA(1, 0), a3, voffA);
            PG8_BAR; PG8_WAIT_L(0); PG8_MMA(1, 0, At, B0); PG8_BAR; PG8_SCHED;
            PG8_STAGE(PG8_SB(1, 1), b3 + hstep, voffB);
            PG8_WAIT_V(6); PG8_BAR; PG8_MMA(1, 1, At, B1); PG8_BAR;
                    }
        }
        if constexpr (ALIGN_EPI) { if (wr == 0) PG8_BAR; }
        if constexpr (!Epi::AFTER_DRAIN) { E(acc, cur, wr, wc, fr, fq); }
        if (!has_next) break;
#pragma unroll
        for (int a = 0; a < 2; ++a)
#pragma unroll
            for (int b = 0; b < 2; ++b)
#pragma unroll
                for (int m = 0; m < 4; ++m)
#pragma unroll
                    for (int n = 0; n < 2; ++n) acc[a][b][m][n] = (f32x4){0.f, 0.f, 0.f, 0.f};
        cur = nxt; cA = nA; cB = nB; ++ui;
        if constexpr (ALIGN_EPI) { if (wr == 1) PG8_BAR; }
    }
    PG8_WAIT_V(0);
    if constexpr (!ALIGN_EPI) { if (wr == 0) PG8_BAR; }
    PG8_BAR;
    if constexpr (Epi::AFTER_DRAIN) { E.fused(acc, cur, wr, wc, fr, fq, lds, wid, lane); }
#undef PG8_SA
#undef PG8_SB
#undef PG8_STAGE
#undef PG8_LDA
#undef PG8_LDB
#undef PG8_MMA
#undef PG8_WAIT_V
#undef PG8_WAIT_L
#undef PG8_BAR
#undef PG8_SCHED
}
}

DI int pi32(int r) { return (r & ~12) | ((r & 4) << 1) | ((r & 8) >> 1); }
struct KFrag { bf16x8 k[4]; };
struct VFrag { bf16x8 v[2][2]; };
DI void load_k(KFrag& f, const bf16_t* kbase) {
#pragma unroll
    for (int s = 0; s < 4; ++s) f.k[s] = *(const bf16x8*)(kbase + 16 * s);
}
DI void load_v(VFrag& f, const bf16_t* vbase, size_t vld) {
#pragma unroll
    for (int dt = 0; dt < 2; ++dt)
#pragma unroll
        for (int s = 0; s < 2; ++s) f.v[dt][s] = *(const bf16x8*)(vbase + (size_t)(32 * dt) * vld + 16 * s);
}
DI bf16x8 pack8(const f32x16& w, int s) {
    u32x4 p; p.x = pk_bf16(w[8 * s + 0], w[8 * s + 1]); p.y = pk_bf16(w[8 * s + 2], w[8 * s + 3]); p.z = pk_bf16(w[8 * s + 4], w[8 * s + 5]); p.w = pk_bf16(w[8 * s + 6], w[8 * s + 7]);
    return __builtin_bit_cast(bf16x8, p);
}
DI void pv_mma(const VFrag& f, const f32x16& w, f32x16& o0, f32x16& o1) {
#pragma unroll
    for (int s = 0; s < 2; ++s) { const bf16x8 pf = pack8(w, s); o0 = MFMA32(f.v[0][s], pf, o0); o1 = MFMA32(f.v[1][s], pf, o1); }
}
DI f32x16 qk_mma(const KFrag& f, const bf16x8 (&qf)[4]) {
    f32x16 st;
#pragma unroll
    for (int i = 0; i < 16; ++i) st[i] = 0.f;
#pragma unroll
    for (int s = 0; s < 4; ++s) st = MFMA32(f.k[s], qf[s], st);
    return st;
}

template <bool DIAG> DI void sb_tile(const KFrag& kf, const VFrag& vf, const bf16x8 (&qf)[4], float& F, f32x16& o0, f32x16& o1, int r, int hh) {
    const f32x16 st = qk_mma(kf, qf);
    f32x16 w; float M[2];
#pragma unroll
    for (int run = 0; run < 2; ++run) {
        float E = 1.f;
#pragma unroll
        for (int e = 7; e >= 0; --e) { const int i = 8 * run + e;
            const float ex = __builtin_amdgcn_exp2f(__builtin_fminf(st[i], 100.f));
            float sc = __builtin_amdgcn_rcpf(1.0f + ex), beta = ex * sc;
            if (DIAG) { if (e + 8 * hh + 16 * run >= r) { sc = 1.f; beta = 0.f; } }
            w[i] = beta * E; E *= sc; }
        M[run] = E;
    }
    const float P0 = __shfl_xor(M[0], 32), P1 = __shfl_xor(M[1], 32);
    const float off1 = F * (hh == 0 ? P1 : 1.f);
    const float off0 = F * (M[1] * P1) * (hh == 0 ? P0 : 1.f);
    F = F * (M[0] * P0) * (M[1] * P1);
#pragma unroll
    for (int i = 0; i < 16; ++i) w[i] *= (i < 8 ? off0 : off1);
    pv_mma(vf, w, o0, o1);
}
DI void mem_tile(const KFrag& kf, const VFrag& vf, const bf16x8 (&qf)[4], float& mx, float& lsum, f32x16& m0, f32x16& m1) {
    const f32x16 st = qk_mma(kf, qf);
    float tm = st[0];
#pragma unroll
    for (int i = 1; i < 16; ++i) tm = __builtin_fmaxf(tm, st[i]);
    tm = __builtin_fmaxf(tm, __shfl_xor(tm, 32));
    const float nm = __builtin_fmaxf(mx, tm), alpha = __builtin_amdgcn_exp2f(mx - nm); mx = nm;
    f32x16 w; float ps = 0.f;
#pragma unroll
    for (int i = 0; i < 16; ++i) { w[i] = __builtin_amdgcn_exp2f(st[i] - nm); ps += w[i]; }
    lsum = lsum * alpha + ps;
#pragma unroll
    for (int i = 0; i < 16; ++i) { m0[i] *= alpha; m1[i] *= alpha; }
    pv_mma(vf, w, m0, m1);
}
DI int gate_off(int tr, int ch) { return tr * 2048 + (ch >> 9) * 1024 + ((((ch & 511) >> 3) ^ (tr & 15)) << 4) + (ch & 7) * 2; }
DI void store_head(const f32x16& o0, const f32x16& o1, float rs, const unsigned char* gl, int tr, int ch0, const float* gs, bf16_t* yp) {
    u32x2 gt[8]; f32x4 gv[8];
#pragma unroll
    for (int q = 0; q < 8; ++q) { const int d = 32 * (q >> 2) + 8 * (q & 3); gt[q] = *(const u32x2*)(gl + gate_off(tr, ch0 + d)); gv[q] = *(const f32x4*)(gs + d); }
#pragma unroll
    for (int q = 0; q < 8; ++q) { const int d = 32 * (q >> 2) + 8 * (q & 3), g = q & 3;
        const f32x16& o = (q >> 2) ? o1 : o0;
        u32x2 w; w.x = pk_bf16(o[4 * g + 0] * rs * gv[q][0] * silu(bf_lo(gt[q].x)), o[4 * g + 1] * rs * gv[q][1] * silu(bf_hi(gt[q].x)));
        w.y = pk_bf16(o[4 * g + 2] * rs * gv[q][2] * silu(bf_lo(gt[q].y)), o[4 * g + 3] * rs * gv[q][3] * silu(bf_hi(gt[q].y)));
        *(u32x2*)(yp + d) = w; }
}
DI float ssq32(const f32x16& a, const f32x16& b) {
    float ss = 0.f;
#pragma unroll
    for (int i = 0; i < 16; ++i) ss += a[i] * a[i] + b[i] * b[i];
    return ss + __shfl_xor(ss, 32);
}
struct ConvW { f32x4 w0a, w0b, w1a, w1b, w2a, w2b, ba, bb; };
DI void conv_tok(const ConvW& cw, const bf16_t* RR, int t, int ch, float (&y)[8]) {
    const int t1 = t >= 1 ? t - 1 : 0, t2 = t >= 2 ? t - 2 : 0;
    const float k1 = t >= 1 ? 1.f : 0.f, k2 = t >= 2 ? 1.f : 0.f;
    const bf16_t* rp0 = RR + (size_t)t * 2048 + ch; const bf16_t* rp1 = RR + (size_t)t1 * 2048 + ch; const bf16_t* rp2 = RR + (size_t)t2 * 2048 + ch;
    const u32x4 u0 = *(const u32x4*)rp0, b0 = *(const u32x4*)(rp0 + 256), c0 = *(const u32x4*)(rp0 + 512);
    const u32x4 u1 = *(const u32x4*)rp1, c1 = *(const u32x4*)(rp1 + 512), u2 = *(const u32x4*)rp2, c2 = *(const u32x4*)(rp2 + 512);
#pragma unroll
    for (int e2 = 0; e2 < 4; ++e2) {
        const int j = (2 * e2) & 3;
        const f32x4& w0 = e2 < 2 ? cw.w0a : cw.w0b; const f32x4& w1 = e2 < 2 ? cw.w1a : cw.w1b; const f32x4& w2 = e2 < 2 ? cw.w2a : cw.w2b; const f32x4& bb = e2 < 2 ? cw.ba : cw.bb;
        y[2 * e2] = bf_lo(b0[e2]) * (w0[j] * (k2 * bf_lo(u2[e2]) * bf_lo(c2[e2])) + w1[j] * (k1 * bf_lo(u1[e2]) * bf_lo(c1[e2])) + w2[j] * (bf_lo(u0[e2]) * bf_lo(c0[e2])) + bb[j]);
        y[2 * e2 + 1] = bf_hi(b0[e2]) * (w0[j + 1] * (k2 * bf_hi(u2[e2]) * bf_hi(c2[e2])) + w1[j + 1] * (k1 * bf_hi(u1[e2]) * bf_hi(c1[e2])) + w2[j + 1] * (bf_hi(u0[e2]) * bf_hi(c0[e2])) + bb[j + 1]);
    }
}
#define ZERO16(v) do { _Pragma("unroll") for (int _i = 0; _i < 16; ++_i) (v)[_i] = 0.f; } while (0)

DI void mixer_phase(const Params& p, unsigned char* ldsraw) {
    float* lf = (float*)ldsraw;
    int tid = threadIdx.x; asm volatile("" : "+v"(tid));
    const int wid = __builtin_amdgcn_readfirstlane(tid >> 6), lane = tid & 63;
    const bf16_t* QK = (const bf16_t*)(p.ws + WS_QK);
    const bf16_t* VT = (const bf16_t*)(p.ws + WS_VT);
    const bf16_t* RR = (const bf16_t*)(p.ws + WS_R);
    const bf16_t* MK = (const bf16_t*)(p.ws + WS_MK);
    const bf16_t* MVT = (const bf16_t*)(p.ws + WS_MVT);
    bf16_t* Y = (bf16_t*)(p.ws + WS_Y);
    for (int it = blockIdx.x; it < T / 64; it += gridDim.x) {
        const int item = ((it & 7) << 5) | (it >> 3);
        int ln = lane; asm volatile("" : "+v"(ln));
        const int r = ln & 31, hh = ln >> 5, pr = pi32(r);
        const int t0 = item * 64, tqA = t0 + r, tqB = tqA + 32;
        {
#pragma unroll 4
            for (int j = 0; j < 16; ++j) { const int q = wid * 16 + j, tr = q >> 1, half = q & 1;
                __builtin_amdgcn_global_load_lds((const unsigned*)(RR + (size_t)(t0 + tr) * 2048 + 1024 + half * 512 + ((ln ^ (tr & 15)) << 3)), (LAS unsigned*)((LAS unsigned char*)ldsraw + 4096 + tr * 2048 + half * 1024), 16, 0, 0); }
        }
        const unsigned char* gl = ldsraw + 4096;
        {
            f32x16 oA0, oA1, oB0, oB1; ZERO16(oA0); ZERO16(oA1); ZERO16(oB0); ZERO16(oB1);
            bf16x8 qfA[4], qfB[4];
            { const bf16_t* qp = QK + (size_t)tqA * 1024 + 64 * wid + 8 * hh;
#pragma unroll
              for (int s = 0; s < 4; ++s) { qfA[s] = *(const bf16x8*)(qp + 16 * s); qfB[s] = *(const bf16x8*)(qp + 32 * 1024 + 16 * s); } }
            const bf16_t* kb = QK + (size_t)pr * 1024 + 512 + 64 * wid + 8 * hh;
            const bf16_t* vb = VT + (size_t)(64 * wid + r) * T + 8 * hh;
            float FA = 1.f, FB = 1.f;
            KFrag kc, kn; VFrag vc, vn;
            load_k(kc, kb + (size_t)(t0 + 32) * 1024); load_v(vc, vb + t0 + 32, T); load_k(kn, kb + (size_t)t0 * 1024); load_v(vn, vb + t0, T);
            sb_tile<true>(kc, vc, qfB, FB, oB0, oB1, r, hh);
            kc = kn; vc = vn;
            int key0 = t0 - 32;
            if (key0 >= 0) { load_k(kn, kb + (size_t)key0 * 1024); load_v(vn, vb + key0, T); }
            sb_tile<true>(kc, vc, qfA, FA, oA0, oA1, r, hh);
            sb_tile<false>(kc, vc, qfB, FB, oB0, oB1, r, hh);
#pragma unroll 1
            while (key0 >= 0) {
                const bool actA = __builtin_amdgcn_ballot_w64(FA >= SB_STOP_F) != 0ull, actB = __builtin_amdgcn_ballot_w64(FB >= SB_STOP_F) != 0ull;
                if (!actA && !actB) break;
                kc = kn; vc = vn;
                if (key0 >= 32) { load_k(kn, kb + (size_t)(key0 - 32) * 1024); load_v(vn, vb + key0 - 32, T); }
                if (actA) sb_tile<false>(kc, vc, qfA, FA, oA0, oA1, r, hh);
                if (actB) sb_tile<false>(kc, vc, qfB, FB, oB0, oB1, r, hh);
                key0 -= 32;
            }
            const float sA = ssq32(oA0, oA1), sB = ssq32(oB0, oB1);
            if (hh == 0) { lf[wid * 32 + r] = sA; lf[256 + wid * 32 + r] = sB; }
            asm volatile("s_waitcnt vmcnt(0)" ::: "memory");
            __syncthreads();
            float totA = 0.f, totB = 0.f;
#pragma unroll
            for (int w8 = 0; w8 < 8; ++w8) { totA += lf[w8 * 32 + r]; totB += lf[256 + w8 * 32 + r]; }
            const float* gs = p.g_sb + 64 * wid + 4 * hh;
            store_head(oA0, oA1, rsqrtf(totA * (1.0f / 512.0f) + EPS), gl, r, 64 * wid + 4 * hh, gs, Y + (size_t)tqA * 1024 + 64 * wid + 4 * hh);
            store_head(oB0, oB1, rsqrtf(totB * (1.0f / 512.0f) + EPS), gl, r + 32, 64 * wid + 4 * hh, gs, Y + (size_t)tqB * 1024 + 64 * wid + 4 * hh);
        }
        {
            f32x16 a0, a1, b0, b1; ZERO16(a0); ZERO16(a1); ZERO16(b0); ZERO16(b1);
            if (wid < 4) {
                bf16x8 qfA[4], qfB[4];
                { const bf16_t* qp = RR + (size_t)tqA * 2048 + 768 + 64 * wid + 8 * hh;
#pragma unroll
                  for (int s = 0; s < 4; ++s) { qfA[s] = *(const bf16x8*)(qp + 16 * s); qfB[s] = *(const bf16x8*)(qp + 32 * 2048 + 16 * s); } }
                const bf16_t* kb = MK + (size_t)pr * 256 + 64 * wid + 8 * hh;
                const bf16_t* vb = MVT + (size_t)(64 * wid + r) * 256 + 8 * hh;
                float mxA = -1e30f, lsA = 0.f, mxB = -1e30f, lsB = 0.f;
                KFrag kc, kn; VFrag vc, vn;
                load_k(kc, kb); load_v(vc, vb, 256);
#pragma unroll 1
                for (int mt = 0; mt < 8; ++mt) {
                    const int nx = mt < 7 ? mt + 1 : 7;
                    load_k(kn, kb + (size_t)(32 * nx) * 256); load_v(vn, vb + 32 * nx, 256);
                    mem_tile(kc, vc, qfA, mxA, lsA, a0, a1);
                    mem_tile(kc, vc, qfB, mxB, lsB, b0, b1);
                    kc = kn; vc = vn;
                }
                lsA += __shfl_xor(lsA, 32); lsB += __shfl_xor(lsB, 32);
                const float iA = 1.0f / lsA, iB = 1.0f / lsB;
#pragma unroll
                for (int i = 0; i < 16; ++i) { a0[i] *= iA; a1[i] *= iA; b0[i] *= iB; b1[i] *= iB; }
                const float sA = ssq32(a0, a1), sB = ssq32(b0, b1);
                if (hh == 0) { lf[512 + wid * 32 + r] = sA; lf[640 + wid * 32 + r] = sB; }
            } else {
                const int cgp = wid - 4, chunk = ln & 7, trow = ln >> 3, ch = 64 * cgp + 8 * chunk;
                ConvW cw; { const float* wp = p.conv_w + ch; const float* bp = p.conv_b + ch;
                    cw.w0a = *(const f32x4*)wp; cw.w0b = *(const f32x4*)(wp + 4); cw.w1a = *(const f32x4*)(wp + 256); cw.w1b = *(const f32x4*)(wp + 260);
                    cw.w2a = *(const f32x4*)(wp + 512); cw.w2b = *(const f32x4*)(wp + 516); cw.ba = *(const f32x4*)bp; cw.bb = *(const f32x4*)(bp + 4); }
#pragma unroll
                for (int j = 0; j < 8; ++j) {
                    float y[8]; conv_tok(cw, RR, t0 + trow + 8 * j, ch, y);
                    float ss = 0.f;
#pragma unroll
                    for (int e = 0; e < 8; ++e) ss += y[e] * y[e];
                    ss += __shfl_xor(ss, 1); ss += __shfl_xor(ss, 2); ss += __shfl_xor(ss, 4);
                    const int tk = trow + 8 * j;
                    if (chunk == 0) lf[768 + 128 * (tk >> 5) + cgp * 32 + (tk & 31)] = ss;
                    f32x16& dst = (j < 2) ? a0 : (j < 4) ? a1 : (j < 6) ? b0 : b1;
#pragma unroll
                    for (int e = 0; e < 8; ++e) dst[(j & 1) * 8 + e] = y[e];
                    if ((j & 3) == 3) __builtin_amdgcn_sched_barrier(0);
                }
            }
            __syncthreads();
            if (wid < 4) {
                const float totA = (lf[512 + r] + lf[544 + r]) + (lf[576 + r] + lf[608 + r]), totB = (lf[640 + r] + lf[672 + r]) + (lf[704 + r] + lf[736 + r]);
                const float* gs = p.g_memo + 64 * wid + 4 * hh;
                store_head(a0, a1, rsqrtf(totA * (1.0f / 256.0f) + EPS), gl, r, 768 + 64 * wid + 4 * hh, gs, Y + (size_t)tqA * 1024 + 768 + 64 * wid + 4 * hh);
                store_head(b0, b1, rsqrtf(totB * (1.0f / 256.0f) + EPS), gl, r + 32, 768 + 64 * wid + 4 * hh, gs, Y + (size_t)tqB * 1024 + 768 + 64 * wid + 4 * hh);
            } else {
                const int cgp = wid - 4, chunk = ln & 7, trow = ln >> 3, ch = 64 * cgp + 8 * chunk;
                const f32x4 ga = *(const f32x4*)(p.g_conv + ch), gb = *(const f32x4*)(p.g_conv + ch + 4);
                u32x4 gt[8]; float rsv[8];
#pragma unroll
                for (int j = 0; j < 8; ++j) { const int tk = trow + 8 * j; const float* lp = lf + 768 + 128 * (tk >> 5) + (tk & 31);
                    rsv[j] = rsqrtf(((lp[0] + lp[32]) + (lp[64] + lp[96])) * (1.0f / 256.0f) + EPS);
                    gt[j] = *(const u32x4*)(gl + gate_off(tk, 512 + ch)); }
#pragma unroll
                for (int j = 0; j < 8; ++j) { const int tk = trow + 8 * j;
                    const f32x16& o = (j < 2) ? a0 : (j < 4) ? a1 : (j < 6) ? b0 : b1; const int b8 = (j & 1) * 8; const float rs = rsv[j];
                    u32x4 w; w.x = pk_bf16(o[b8 + 0] * rs * ga[0] * silu(bf_lo(gt[j].x)), o[b8 + 1] * rs * ga[1] * silu(bf_hi(gt[j].x)));
                    w.y = pk_bf16(o[b8 + 2] * rs * ga[2] * silu(bf_lo(gt[j].y)), o[b8 + 3] * rs * ga[3] * silu(bf_hi(gt[j].y)));
                    w.z = pk_bf16(o[b8 + 4] * rs * gb[0] * silu(bf_lo(gt[j].z)), o[b8 + 5] * rs * gb[1] * silu(bf_hi(gt[j].z)));
                    w.w = pk_bf16(o[b8 + 6] * rs * gb[2] * silu(bf_lo(gt[j].w)), o[b8 + 7] * rs * gb[3] * silu(bf_hi(gt[j].w)));
                    *(u32x4*)(Y + (size_t)(t0 + tk) * 1024 + 512 + ch) = w; }
            }
        }
        __syncthreads();
    }
}

DI void finalnorm_phase(const Params& p) {
    const float* ssq = (const float*)(p.ws + WS_SSQ);
    const int wid = threadIdx.x >> 6, lane = threadIdx.x & 63;
    for (int row = blockIdx.x * 8 + wid; row < T; row += gridDim.x * 8) {
        const float tot = (ssq[row] + ssq[T + row]) + (ssq[2 * T + row] + ssq[3 * T + row]);
        const float rs = rsqrtf(tot * (1.0f / 1024.0f) + EPS);
        float* o = p.out + (size_t)row * D;
#pragma unroll
        for (int j = 0; j < 4; ++j) { f32x4 v = *(f32x4*)(o + 256 * j + 4 * lane); const f32x4 g = *(const f32x4*)(p.g_final + 256 * j + 4 * lane); *(f32x4*)(o + 256 * j + 4 * lane) = v * rs * g; }
    }
}

#define ZERO_ACC(acc) do { _Pragma("unroll") for (int _a = 0; _a < 2; ++_a) _Pragma("unroll") for (int _b = 0; _b < 2; ++_b) _Pragma("unroll") for (int _m = 0; _m < 4; ++_m) _Pragma("unroll") for (int _n = 0; _n < 2; ++_n) \
    (acc)[_a][_b][_m][_n] = (f32x4){0.f, 0.f, 0.f, 0.f}; } while (0)
template <int PH> __global__ void __launch_bounds__(512, 2) fwd(Params p) {
    extern __shared__ __attribute__((aligned(16))) unsigned char lds[];
    XcdBarrier xb{};
    if (PH < 0) {
        if (p.ws == nullptr) cg::this_grid().sync();
        volatile LAS unsigned* st = (volatile LAS unsigned*)((LAS unsigned char*)lds + LDS_MAIN);
        if (threadIdx.x == 0) { st[0] = 0u; st[1] = 0u; }
        __syncthreads();
        xb = xcd_barrier_post((unsigned*)(p.ws + WS_BAR), st);
    }
    if (PH < 0 || PH == 0) prep_phase(p, lds);
#if PROBE_DUP == 0
    if (PH < 0) { xcd_barrier(xb); prep_phase(p, lds); }
#endif
    if (PH < 0) xcd_barrier(xb);
    if (PH < 0 || PH == 1) {
        pg8::Gemm g; g.A = (const bf16_t*)(p.ws + WS_OPS); g.Bt = g.A; g.K = 1024;
        pg8::ProjOrder S; S.G = gridDim.x; S.c = blockIdx.x;
        pg8::EpiProj E; E.qk = (bf16_t*)(p.ws + WS_QK); E.vt = (bf16_t*)(p.ws + WS_VT); E.r = (bf16_t*)(p.ws + WS_R); E.mk = (bf16_t*)(p.ws + WS_MK); E.mvt = (bf16_t*)(p.ws + WS_MVT);
        f32x4 acc[2][2][4][2]; ZERO_ACC(acc);
        pg8::gemm_phase<pg8::EpiProj, pg8::ProjOrder, true>((LAS unsigned char*)lds, g, S, E, acc);
    }
    if (PH < 0) xcd_barrier(xb);
    if (PH < 0 || PH == 2) mixer_phase(p, lds);
#if PROBE_DUP == 2
    if (PH < 0) { xcd_barrier(xb); mixer_phase(p, lds); }
#endif
    if (PH < 0 || PH == 3) {
        pg8::Gemm g; g.A = (const bf16_t*)(p.ws + WS_Y); g.Bt = (const bf16_t*)(p.ws + WS_WOUT); g.K = 1024;
        pg8::OutOrder S; S.G = gridDim.x; S.c = blockIdx.x;
        pg8::EpiFinal<(PH < 0)> E; E.x = p.x; E.gf = p.g_final; E.out = p.out; E.ssq = (float*)(p.ws + WS_SSQ); E.xb = xb; E.pcnt = (unsigned*)(p.ws + WS_PCNT);
        f32x4 acc[2][2][4][2];
        pg8::Unit u0; const bool has = S.next(0, u0);
        int tid = threadIdx.x; asm volatile("" : "+v"(tid));
        auto hook = [&]() { if (has) E.load_x(acc, u0, tid); };
        if (PH < 0) xcd_barrier(xb, hook); else hook();
        pg8::gemm_phase<pg8::EpiFinal<(PH < 0)>, pg8::OutOrder>((LAS unsigned char*)lds, g, S, E, acc);
    }
    if (PH == 4) finalnorm_phase(p);
}

extern "C" void kernel_launch(void* const* d_in, const int* in_sizes, int n_in, void* d_out, int out_size, void* d_ws, size_t ws_size, hipStream_t stream) {
    constexpr int LDS_BYTES = LDS_MAIN + 16;
    static int ready = 0;
    if (!ready) {
        if (n_in != 13 || ws_size < WS_END) { fprintf(stderr, "kernel_launch: unexpected inputs (n_in %d, ws %zu < %zu)\n", n_in, ws_size, (size_t)WS_END); ready = -1; return; }
        (void)hipFuncSetAttribute((const void*)fwd<-1>, hipFuncAttributeMaxDynamicSharedMemorySize, LDS_BYTES);
        (void)hipFuncSetAttribute((const void*)fwd<0>, hipFuncAttributeMaxDynamicSharedMemorySize, LDS_BYTES);
        (void)hipFuncSetAttribute((const void*)fwd<1>, hipFuncAttributeMaxDynamicSharedMemorySize, LDS_BYTES);
        (void)hipFuncSetAttribute((const void*)fwd<2>, hipFuncAttributeMaxDynamicSharedMemorySize, LDS_BYTES);
        (void)hipFuncSetAttribute((const void*)fwd<3>, hipFuncAttributeMaxDynamicSharedMemorySize, LDS_BYTES);
        (void)hipFuncSetAttribute((const void*)fwd<4>, hipFuncAttributeMaxDynamicSharedMemorySize, LDS_BYTES);
        ready = 1;
    }
    if (ready < 0) return;
    Params p{};
    p.x = (const float*)d_in[0]; p.mem = (const float*)d_in[1]; p.g_in = (const float*)d_in[2]; p.w_in = (const float*)d_in[3]; p.conv_w = (const float*)d_in[4];
    p.conv_b = (const float*)d_in[5]; p.g_mem = (const float*)d_in[6]; p.w_kv = (const float*)d_in[7]; p.g_sb = (const float*)d_in[8]; p.g_conv = (const float*)d_in[9];
    p.g_memo = (const float*)d_in[10]; p.w_out = (const float*)d_in[11]; p.g_final = (const float*)d_in[12];
    p.out = (float*)d_out; p.ws = (unsigned char*)d_ws;
    const int grid = 256;
#if COOP
    (void)hipMemsetAsync((unsigned char*)d_ws + WS_BAR, 0, (size_t)XCD_BAR_WORDS * 4 + (size_t)64 * 256, stream);
    void* args[] = {&p};
    hipError_t e = hipLaunchCooperativeKernel((const void*)fwd<-1>, dim3(grid), dim3(512), args, LDS_BYTES, stream);
    if (e != hipSuccess) fprintf(stderr, "cooperative launch failed: %s\n", hipGetErrorString(e));
#else
    hipLaunchKernelGGL(fwd<0>, dim3(grid), dim3(512), LDS_BYTES, stream, p);
    hipLaunchKernelGGL(fwd<1>, dim3(grid), dim3(512), LDS_BYTES, stream, p);
    hipLaunchKernelGGL(fwd<2>, dim3(grid), dim3(512), LDS_BYTES, stream, p);
    hipLaunchKernelGGL(fwd<3>, dim3(grid), dim3(512), LDS_BYTES, stream, p);
    hipLaunchKernelGGL(fwd<4>, dim3(grid), dim3(512), LDS_BYTES, stream, p);
#endif
}
```

```cpp
#include <hip/hip_runtime.h>
#include <hip/hip_cooperative_groups.h>
#include <cstdio>
namespace cg = cooperative_groups;

#ifndef COOP
#define COOP 1
#endif
#ifndef PROBE_DUP
#define PROBE_DUP -1
#endif

#define LAS __attribute__((address_space(3)))
typedef unsigned short bf16_t;
typedef short bf16x8 __attribute__((ext_vector_type(8)));
typedef short s16x4 __attribute__((ext_vector_type(4)));
typedef float f32x4 __attribute__((ext_vector_type(4)));
typedef float f32x2 __attribute__((ext_vector_type(2)));
typedef float f32x16 __attribute__((ext_vector_type(16)));
typedef unsigned u32x4 __attribute__((ext_vector_type(4)));
typedef unsigned u32x2 __attribute__((ext_vector_type(2)));
typedef __bf16 bf2_t __attribute__((ext_vector_type(2)));
#define DI __device__ __forceinline__

constexpr int T = 16384, D = 1024, PROJ = 3584, NMEM = 256;
constexpr float EPS = 1e-6f;
constexpr float QSCALE = 0.125f * 1.4426950408889634f;
constexpr float SB_STOP_F = 0x1p-48f;
constexpr int XCD_BAR_WORDS_C = 3456;
constexpr int LDS_MAIN = 4096 + 64 * 2048;

constexpr size_t OPS_ROWS = 16384 + 256 + 3584 + 512;
constexpr size_t WS_OPS = 0;
constexpr size_t WS_WOUT = WS_OPS + OPS_ROWS * 2048;
constexpr size_t WS_QK = WS_WOUT + (size_t)1024 * 2048;
constexpr size_t WS_VT = WS_QK + (size_t)T * 2048;
constexpr size_t WS_R = WS_VT + (size_t)512 * T * 2;
constexpr size_t WS_MK = WS_R + (size_t)T * 4096;
constexpr size_t WS_MVT = WS_MK + (size_t)256 * 512;
constexpr size_t WS_Y = WS_OPS;
constexpr size_t WS_SSQ = WS_MVT + (size_t)256 * 512;
constexpr size_t WS_BAR = WS_SSQ + (size_t)4 * T * 4;
constexpr size_t WS_PCNT = WS_BAR + (size_t)XCD_BAR_WORDS_C * 4;
constexpr size_t WS_LBAR = WS_PCNT + (size_t)64 * 256;
constexpr size_t WS_END = WS_LBAR + (size_t)32 * 256;

struct Params {
    const float *x, *mem, *g_in, *w_in, *conv_w, *conv_b, *g_mem, *w_kv, *g_sb, *g_conv, *g_memo, *w_out, *g_final;
    float* out;
    unsigned char* ws;
};

DI unsigned pk_bf16(float lo, float hi) { f32x2 v = {lo, hi}; bf2_t b = __builtin_convertvector(v, bf2_t); return __builtin_bit_cast(unsigned, b); }
DI float bf_lo(unsigned u) { return __uint_as_float(u << 16); }
DI float bf_hi(unsigned u) { return __uint_as_float(u & 0xffff0000u); }
DI float wave_sum(float v) { v += __shfl_xor(v, 32); v += __shfl_xor(v, 16); v += __shfl_xor(v, 8); v += __shfl_xor(v, 4); v += __shfl_xor(v, 2); v += __shfl_xor(v, 1); return v; }
DI float silu(float x) { return x * __builtin_amdgcn_rcpf(1.0f + __builtin_amdgcn_exp2f(-1.4426950408889634f * x)); }
#define MFMA32(a, b, c) __builtin_amdgcn_mfma_f32_32x32x16_bf16((a), (b), (c), 0, 0, 0)

#define XB_TMO      128
#define XB_XCNT(j)  (256  + 64 * (j))
#define XB_XSUB(j)  (1280 + 64 * (j))
#define XB_XGEN(j)  (2304 + 64 * (j))
#define XB_TOP      3328
#define XB_TOPGEN   3392
#define XCD_BAR_WORDS 3456
#define XB_SPIN_CAP (1u << 18)
DI unsigned xb_ld(unsigned* p)              { return __hip_atomic_load(p, __ATOMIC_RELAXED, __HIP_MEMORY_SCOPE_AGENT); }
DI unsigned xb_add(unsigned* p, unsigned v) { return __hip_atomic_fetch_add(p, v, __ATOMIC_RELAXED, __HIP_MEMORY_SCOPE_AGENT); }
DI unsigned xb_xcc_id() { return (unsigned)__builtin_amdgcn_s_getreg((3 << 11) | 20) & 0xFu; }
#define XB_SPIN(cond, bar) do { unsigned _sp = 0; while (cond) { __builtin_amdgcn_s_sleep(1); \
    if ((++_sp & 255u) == 0u) { if (xb_ld(&(bar)[XB_TMO])) break; if (_sp > XB_SPIN_CAP) { atomicAdd(&(bar)[XB_TMO], 1u); break; } } } } while (0)
struct XcdBarrier { unsigned* bar; unsigned x; volatile LAS unsigned* st; };
DI XcdBarrier xcd_barrier_post(unsigned* bar, volatile LAS unsigned* st) {
    XcdBarrier b; b.bar = bar; b.x = xb_xcc_id(); b.st = st;
    if (threadIdx.x == 0) st[3] = xb_add(&bar[XB_XCNT(b.x)], 1u);
    return b;
}
DI void xcd_barrier_complete(unsigned* bar, unsigned x, unsigned& nloc, unsigned& nx, unsigned& even) {
    const unsigned G = gridDim.x * gridDim.y * gridDim.z;
    unsigned sum, cnt, mine, sp = 0u;
    for (;;) {
        sum = 0u; cnt = 0u; mine = 0u;
#pragma unroll
        for (unsigned j = 0; j < 16; ++j) { const unsigned c = xb_ld(&bar[XB_XCNT(j)]); sum += c; cnt += (c > 0u) ? 1u : 0u; mine = (j == x) ? c : mine; }
        if (sum == G) break;
        __builtin_amdgcn_s_sleep(1);
        if ((++sp & 255u) == 0u) { if (xb_ld(&bar[XB_TMO])) break; if (sp > XB_SPIN_CAP) { atomicAdd(&bar[XB_TMO], 1u); break; } }
    }
    nloc = mine > 0u ? mine : 1u; nx = cnt > 0u ? cnt : 1u;
    unsigned ev = (sum == G && cnt == 8u && (G & 7u) == 0u) ? 1u : 0u;
#pragma unroll
    for (unsigned j = 0; j < 16; ++j) { const unsigned c = xb_ld(&bar[XB_XCNT(j)]); if (c != 0u && (c != (G >> 3) || j >= 8u)) ev = 0u; }
    even = ev;
}
struct NoHook { DI void operator()() const {} };
template <class Hook = NoHook> DI void xcd_barrier(const XcdBarrier& b, const Hook& hook = Hook()) {
    asm volatile("s_waitcnt vmcnt(0)" ::: "memory");
    __syncthreads();
    if (threadIdx.x >= 64) hook();
    if (threadIdx.x == 0) {
        unsigned* bar = b.bar;
        __builtin_amdgcn_s_waitcnt(0);
        unsigned nloc = b.st[0], nx = b.st[1];
        if (nloc == 0u) { unsigned even; xcd_barrier_complete(bar, b.x, nloc, nx, even); b.st[0] = nloc; b.st[1] = nx; b.st[2] = even; }
        const unsigned old = xb_add(&bar[XB_XSUB(b.x)], 1u);
        const unsigned gen = old / nloc;
        if (old + 1u == (gen + 1u) * nloc) {
            __builtin_amdgcn_fence(__ATOMIC_RELEASE, "agent");
            asm volatile("s_waitcnt vmcnt(0)" ::: "memory");
            const unsigned og = xb_add(&bar[XB_TOP], 1u);
            const unsigned tg = og / nx;
            if (og + 1u == (tg + 1u) * nx) xb_add(&bar[XB_TOPGEN], 1u);
            else XB_SPIN(xb_ld(&bar[XB_TOPGEN]) == tg, bar);
            __builtin_amdgcn_fence(__ATOMIC_ACQUIRE, "agent");
            xb_add(&bar[XB_XGEN(b.x)], 1u);
            asm volatile("s_waitcnt vmcnt(0)" ::: "memory");
        } else {
            XB_SPIN(xb_ld(&bar[XB_XGEN(b.x)]) == gen, bar);
            __builtin_amdgcn_fence(__ATOMIC_ACQUIRE, "agent");
            asm volatile("s_waitcnt vmcnt(0)" ::: "memory");
        }
    }
    __syncthreads();
    if (threadIdx.x < 64) hook();
}

DI void prep_row(const f32x4 (&v)[4], const f32x4 (&gg)[4], bf16_t* dst, int lane) {
    float ss = 0.f;
#pragma unroll
    for (int j = 0; j < 4; ++j) ss += (v[j][0] * v[j][0] + v[j][1] * v[j][1]) + (v[j][2] * v[j][2] + v[j][3] * v[j][3]);
    ss = wave_sum(ss);
    const float rs = rsqrtf(ss * (1.0f / 1024.0f) + EPS);
#pragma unroll
    for (int j = 0; j < 4; ++j) {
        u32x2 w; w.x = pk_bf16(v[j][0] * rs * gg[j][0], v[j][1] * rs * gg[j][1]); w.y = pk_bf16(v[j][2] * rs * gg[j][2], v[j][3] * rs * gg[j][3]);
        *(u32x2*)(dst + 256 * j + 4 * lane) = w; }
}
DI void prep_phase(const Params& p, unsigned char* lds) {
    int tid = threadIdx.x; asm volatile("" : "+v"(tid));
    const int wid = tid >> 6, lane = tid & 63;
    bf16_t* ops = (bf16_t*)(p.ws + WS_OPS);
    float* tile = (float*)lds;
    for (int si = blockIdx.x; si < 256; si += gridDim.x) {
        const int kt = si >> 4, ns = si & 15;
        const int row = tid >> 3, c = (tid & 7) * 8;
        f32x4 la[5], lb[5];
#pragma unroll
        for (int j = 0; j < 5; ++j) { const int ti = ns * 5 + j; const float* src; int N, nt;
            if (ti < 56) { src = p.w_in; N = PROJ; nt = ti; } else if (ti < 72) { src = p.w_out; N = 1024; nt = ti - 56; } else { src = p.w_kv; N = 512; nt = ti - 72; }
            const float* sp = src + (size_t)(kt * 64 + row) * N + nt * 64 + c; la[j] = *(const f32x4*)sp; lb[j] = *(const f32x4*)(sp + 4); }
#pragma unroll
        for (int j = 0; j < 5; ++j) { float* tp = tile + j * (64 * 65) + row * 65 + c;
#pragma unroll
            for (int i = 0; i < 4; ++i) { tp[i] = la[j][i]; tp[4 + i] = lb[j][i]; } }
        __syncthreads();
        const int n = tid >> 3, kc = (tid & 7) * 8;
#pragma unroll
        for (int j = 0; j < 5; ++j) { const int ti = ns * 5 + j; bf16_t* dst; int nt;
            if (ti < 56) { dst = ops + (size_t)16640 * 1024; nt = ti; } else if (ti < 72) { dst = (bf16_t*)(p.ws + WS_WOUT); nt = ti - 56; } else { dst = ops + (size_t)20224 * 1024; nt = ti - 72; }
            const float* tp = tile + j * (64 * 65) + n; float v[8];
#pragma unroll
            for (int i = 0; i < 8; ++i) v[i] = tp[(kc + i) * 65];
            u32x4 w; w.x = pk_bf16(v[0], v[1]); w.y = pk_bf16(v[2], v[3]); w.z = pk_bf16(v[4], v[5]); w.w = pk_bf16(v[6], v[7]);
            *(u32x4*)(dst + (size_t)(nt * 64 + n) * 1024 + kt * 64 + kc) = w; }
        __syncthreads();
    }
    const int nw = gridDim.x * 8, gw = blockIdx.x * 8 + wid;
    {
        f32x4 gg[4];
#pragma unroll
        for (int j = 0; j < 4; ++j) gg[j] = *(const f32x4*)(p.g_in + 256 * j + 4 * lane);
        for (int row = gw; row < T; row += 2 * nw) {
            const int rowB = row + nw; const bool hasB = rowB < T; const int rb = hasB ? rowB : row;
            const float* srcA = p.x + (size_t)row * D; const float* srcB = p.x + (size_t)rb * D;
            f32x4 va[4], vb[4];
#pragma unroll
            for (int j = 0; j < 4; ++j) va[j] = *(const f32x4*)(srcA + 256 * j + 4 * lane);
#pragma unroll
            for (int j = 0; j < 4; ++j) vb[j] = *(const f32x4*)(srcB + 256 * j + 4 * lane);
            __builtin_amdgcn_sched_barrier(0);
            prep_row(va, gg, ops + (size_t)row * 1024, lane);
            if (hasB) prep_row(vb, gg, ops + (size_t)rb * 1024, lane);
        }
    }
    if (gw < NMEM) {
        f32x4 gg[4], va[4];
#pragma unroll
        for (int j = 0; j < 4; ++j) { gg[j] = *(const f32x4*)(p.g_mem + 256 * j + 4 * lane); va[j] = *(const f32x4*)(p.mem + (size_t)gw * D + 256 * j + 4 * lane); }
        prep_row(va, gg, ops + (size_t)(T + gw) * 1024, lane);
    }
}

namespace pg8 {
constexpr int BM = 256, BK = 64, HALF = 128, HTB = HALF * BK * 2, STAGE_BYTES = 8 * HTB, NXCD = 8, WGM = 8;
DI int lds_byte(int r, int c) { const int st = (r >> 4) * 2 + (c >> 5), rr = r & 15, cc = c & 31, ob = rr * 64 + cc * 2; return st * 1024 + (ob ^ (((ob >> 9) & 1) << 5)); }
DI void stage_rc(int b, int& R, int& C) { const int st = b / 1024, sb = b % 1024, swz = sb ^ (((sb >> 9) & 1) << 5); R = (st >> 1) * 16 + swz / 64; C = (st & 1) * 32 + (swz % 64) / 2; }
DI int perm32(int rho) { const int n = rho >> 4, i = rho & 15; return 8 * (i >> 2) + 4 * n + (i & 3); }

struct Unit { int pm, pn, kind, om, on; };
struct Gemm { const bf16_t* A; const bf16_t* Bt; int K; };

struct ProjOrder {
    int G, c;
    DI bool next(int i, Unit& u) const {
        const int L = i * G + c;
        if (L >= 898) return false;
        if (L == 896) { u.pm = 64; u.pn = 79; u.kind = 3; u.om = 0; u.on = 0; return true; }
        if (L == 897) { u.pm = 80; u.pn = 64; u.kind = 4; u.om = 0; u.on = 0; return true; }
        const int xcd = L & 7, off = L >> 3, wgid = xcd * 112 + off;
        const int vpm = xcd * 8 + ((wgid % 112) & 7), vpn = (wgid % 112) >> 3;
        if (vpn < 4) { u.pm = vpm; u.pn = 65 + vpn; u.kind = 0; u.om = vpm; u.on = vpn; }
        else if (vpn < 6) { u.pm = 65 + vpn; u.pn = vpm; u.kind = 1; u.om = vpn - 4; u.on = vpm; }
        else { u.pm = vpm; u.pn = 65 + vpn; u.kind = 2; u.om = vpm; u.on = vpn - 6; }
        return true;
    }
};
struct OutOrder {
    int G, c;
    DI bool next(int i, Unit& u) const {
        const int L = i * G + c;
        if (L >= 256) return false;
        const int xcd = L & 7, off = L >> 3;
        u.pm = xcd * 8 + (off & 7); u.pn = off >> 3; u.kind = 0; u.om = u.pm; u.on = u.pn; return true;
    }
};

struct EpiProj {
    static constexpr bool PERM = true, AFTER_DRAIN = false;
    bf16_t *qk, *vt, *r, *mk, *mvt;
    DI void operator()(const f32x4 (&acc)[2][2][4][2], const Unit& u, int wr, int wc, int fr, int fq) const {
        bf16_t* base; int ldc; float sc = 1.0f;
        if (u.kind == 0) { base = qk; ldc = 1024; if (u.on < 2) sc = QSCALE; }
        else if (u.kind == 1) { base = vt; ldc = T; }
        else if (u.kind == 2) { base = r; ldc = 2048; if (u.on == 3) sc = QSCALE; }
        else if (u.kind == 3) { base = mk; ldc = 256; }
        else { base = mvt; ldc = 256; }
        const int row0 = u.om * BM + wr * 64 + fr, col0 = u.on * BM + wc * 32 + 8 * fq;
#pragma unroll
        for (int ai = 0; ai < 2; ++ai)
#pragma unroll
            for (int m = 0; m < 4; ++m) { bf16_t* rowp = base + (size_t)(row0 + ai * HALF + m * 16) * ldc + col0;
#pragma unroll
                for (int bj = 0; bj < 2; ++bj) { const f32x4 v0 = acc[ai][bj][m][0] * sc, v1 = acc[ai][bj][m][1] * sc;
                    u32x4 w; w.x = pk_bf16(v0[0], v0[1]); w.y = pk_bf16(v0[2], v0[3]); w.z = pk_bf16(v1[0], v1[1]); w.w = pk_bf16(v1[2], v1[3]);
                    *(u32x4*)(rowp + bj * HALF) = w; } }
    }
};

template <bool FUSE_SYNC> struct EpiFinal {
    static constexpr bool PERM = false, AFTER_DRAIN = true;
    const float* x; const float* gf; float* out; float* ssq; XcdBarrier xb; unsigned* pcnt;
    DI void load_x(f32x4 (&acc)[2][2][4][2], const Unit& u, int tid) const {
        const int wid = tid >> 6, lane = tid & 63, wr = wid >> 2, wc = wid & 3, fr = lane & 15, fq = lane >> 4;
        const int row0 = u.pm * BM + wr * 64 + fr, col0 = u.pn * BM + wc * 32 + 4 * fq;
#pragma unroll
        for (int ai = 0; ai < 2; ++ai)
#pragma unroll
            for (int m = 0; m < 4; ++m) { const float* xr = x + (size_t)(row0 + ai * HALF + m * 16) * D + col0;
#pragma unroll
                for (int bj = 0; bj < 2; ++bj)
#pragma unroll
                    for (int n = 0; n < 2; ++n) acc[ai][bj][m][n] = *(const f32x4*)(xr + bj * HALF + n * 16); }
    }
    DI void fused(f32x4 (&acc)[2][2][4][2], const Unit& u, int wr, int wc, int fr, int fq, LAS unsigned char* lds, int wid, int lane) const {
        LAS float* P = (LAS float*)lds;
        const int row0 = u.pm * BM + wr * 64 + fr, col0 = u.pn * BM + wc * 32 + 4 * fq;
#pragma unroll
        for (int ai = 0; ai < 2; ++ai)
#pragma unroll
            for (int m = 0; m < 4; ++m) { float s = 0.f;
#pragma unroll
                for (int bj = 0; bj < 2; ++bj)
#pragma unroll
                    for (int n = 0; n < 2; ++n) { const f32x4 a = acc[ai][bj][m][n]; s += (a[0] * a[0] + a[1] * a[1]) + (a[2] * a[2] + a[3] * a[3]); }
                s += __shfl_xor(s, 16); s += __shfl_xor(s, 32);
                if (fq == 0) P[(ai * HALF + wr * 64 + m * 16 + fr) * 4 + wc] = s; }
        __syncthreads();
        if constexpr (!FUSE_SYNC) { if (wid * 64 + lane < 256) { const int rr = wid * 64 + lane; const float s = (P[rr * 4 + 0] + P[rr * 4 + 1]) + (P[rr * 4 + 2] + P[rr * 4 + 3]); ssq[(size_t)u.pn * T + u.pm * BM + rr] = s; } }
        if constexpr (FUSE_SYNC) {
            unsigned* slots = (unsigned*)ssq; unsigned* cnt = pcnt + 64 * u.pm;
            if (wid < 4) { const int rr = wid * 64 + lane; const float s = (P[rr * 4 + 0] + P[rr * 4 + 1]) + (P[rr * 4 + 2] + P[rr * 4 + 3]);
                __hip_atomic_store(slots + (size_t)u.pn * T + u.pm * BM + rr, __float_as_uint(s), __ATOMIC_RELAXED, __HIP_MEMORY_SCOPE_AGENT);
                asm volatile("s_waitcnt vmcnt(0)" ::: "memory");
                if (lane == 0) __hip_atomic_fetch_add(cnt, 1u, __ATOMIC_RELAXED, __HIP_MEMORY_SCOPE_AGENT); }
            if (wid == 0) {
                unsigned polls = 0;
                while ((unsigned)__builtin_amdgcn_readfirstlane(__hip_atomic_load(cnt, __ATOMIC_RELAXED, __HIP_MEMORY_SCOPE_AGENT)) < 16u) { if (++polls > (1u << 20)) break; __builtin_amdgcn_s_sleep(1); }
                __builtin_amdgcn_fence(__ATOMIC_ACQUIRE, "agent");
            }
            asm volatile("s_waitcnt vmcnt(0) lgkmcnt(0)" ::: "memory"); __builtin_amdgcn_s_barrier(); asm volatile("" ::: "memory");
            float rs[2][4]; f32x4 gv[2][2];
#pragma unroll
            for (int ai = 0; ai < 2; ++ai)
#pragma unroll
                for (int m = 0; m < 4; ++m) { const int row = row0 + ai * HALF + m * 16;
                    const float tot = (__uint_as_float(__hip_atomic_load(slots + row, __ATOMIC_RELAXED, __HIP_MEMORY_SCOPE_AGENT)) + __uint_as_float(__hip_atomic_load(slots + T + row, __ATOMIC_RELAXED, __HIP_MEMORY_SCOPE_AGENT)))
                                    + (__uint_as_float(__hip_atomic_load(slots + 2 * T + row, __ATOMIC_RELAXED, __HIP_MEMORY_SCOPE_AGENT)) + __uint_as_float(__hip_atomic_load(slots + 3 * T + row, __ATOMIC_RELAXED, __HIP_MEMORY_SCOPE_AGENT)));
                    rs[ai][m] = rsqrtf(tot * (1.0f / 1024.0f) + EPS); }
#pragma unroll
            for (int bj = 0; bj < 2; ++bj)
#pragma unroll
                for (int n = 0; n < 2; ++n) gv[bj][n] = *(const f32x4*)(gf + col0 + bj * HALF + n * 16);
#pragma unroll
            for (int ai = 0; ai < 2; ++ai)
#pragma unroll
                for (int m = 0; m < 4; ++m) { float* orow = out + (size_t)(row0 + ai * HALF + m * 16) * D + col0;
#pragma unroll
                    for (int bj = 0; bj < 2; ++bj)
#pragma unroll
                        for (int n = 0; n < 2; ++n) *(f32x4*)(orow + bj * HALF + n * 16) = acc[ai][bj][m][n] * rs[ai][m] * gv[bj][n]; }
        } else {
#pragma unroll
            for (int ai = 0; ai < 2; ++ai)
#pragma unroll
                for (int m = 0; m < 4; ++m) { float* orow = out + (size_t)(row0 + ai * HALF + m * 16) * D + col0;
#pragma unroll
                    for (int bj = 0; bj < 2; ++bj)
#pragma unroll
                        for (int n = 0; n < 2; ++n) *(f32x4*)(orow + bj * HALF + n * 16) = acc[ai][bj][m][n]; }
        }
    }
    DI void operator()(const f32x4 (&)[2][2][4][2], const Unit&, int, int, int, int) const {}
};

template <class Epi, class Sched, bool ALIGN_EPI = false, bool SP2 = true>
DI void gemm_phase(LAS unsigned char* lds, const Gemm g, const Sched& S, const Epi& E, f32x4 (&acc)[2][2][4][2]) {
    int tid = threadIdx.x; asm volatile("" : "+v"(tid));
    const int wid = __builtin_amdgcn_readfirstlane(tid >> 6), lane = tid & 63, wr = wid >> 2, wc = wid & 3, fr = lane & 15, fq = lane >> 4;
    const int K = g.K, nt = K / BK;
    unsigned voffA[2], voffB[2];
#pragma unroll
    for (int i = 0; i < 2; ++i) { int R, C; stage_rc(tid * 16 + i * 8192, R, C); const int Rb = Epi::PERM ? ((R & ~31) + perm32(R & 31)) : R;
        voffA[i] = (unsigned)(R * K + C) * 2u; voffB[i] = (unsigned)(Rb * K + C) * 2u; }
    const size_t kstep = (size_t)(BK * 2);
    const size_t hstep = (size_t)HALF * K * 2;
    const size_t tstep = 2 * hstep;
    const unsigned ldsw = (unsigned)wid * 1024u;
    const int aoff = lds_byte(wr * 64 + fr, fq * 8), boff = lds_byte(wc * 32 + fr, fq * 8);
#define PG8_SA(b, h) (((b) * 2 + (h)) * HTB)
#define PG8_SB(b, h) ((4 + (b) * 2 + (h)) * HTB)
#define PG8_STAGE(bufoff, gbase, voff) do { _Pragma("unroll") for (int _i = 0; _i < 2; ++_i) \
        __builtin_amdgcn_global_load_lds((const unsigned*)((const char*)(gbase) + (voff)[_i]), (LAS unsigned*)(lds + (bufoff) + ldsw + _i * 8192), 16, 0, 0); } while (0)
#define PG8_LDA(dst, b, h) do { _Pragma("unroll") for (int m = 0; m < 4; ++m) _Pragma("unroll") for (int k = 0; k < 2; ++k) dst[m][k] = *(const LAS bf16x8*)(lds + PG8_SA(b, h) + aoff + m * 2048 + k * 1024); } while (0)
#define PG8_LDB(dst, b, h) do { _Pragma("unroll") for (int n = 0; n < 2; ++n) _Pragma("unroll") for (int k = 0; k < 2; ++k) dst[n][k] = *(const LAS bf16x8*)(lds + PG8_SB(b, h) + boff + n * 2048 + k * 1024); } while (0)
#define PG8_MMA(ai, bj, At, Bt) do { __builtin_amdgcn_s_setprio(1); _Pragma("unroll") for (int m = 0; m < 4; ++m) _Pragma("unroll") for (int n = 0; n < 2; ++n) _Pragma("unroll") for (int k = 0; k < 2; ++k) \
        acc[ai][bj][m][n] = __builtin_amdgcn_mfma_f32_16x16x32_bf16(Bt[n][k], At[m][k], acc[ai][bj][m][n], 0, 0, 0); __builtin_amdgcn_s_setprio(0); } while (0)
#define PG8_WAIT_V(n) asm volatile("s_waitcnt vmcnt(" #n ")" ::: "memory")
#define PG8_WAIT_L(n) asm volatile("s_waitcnt lgkmcnt(" #n ")" ::: "memory")
#define PG8_BAR __builtin_amdgcn_s_barrier()
#define PG8_SCHED __builtin_amdgcn_sched_barrier(0)
    Unit cur, nxt; int ui = 0;
    if (!S.next(0, cur)) return;
    bf16x8 At[4][2], B0[2][2], B1[2][2];
    const char* cA = (const char*)g.A + (size_t)cur.pm * tstep; const char* cB = (const char*)g.Bt + (size_t)cur.pn * tstep;
    if constexpr (SP2) {
        PG8_STAGE(PG8_SB(0, 0), cB, voffB); PG8_STAGE(PG8_SB(0, 1), cB + hstep, voffB); PG8_STAGE(PG8_SA(0, 0), cA, voffA); PG8_STAGE(PG8_SA(0, 1), cA + hstep, voffA);
        if (wr == 1) PG8_BAR;
        PG8_WAIT_V(2); PG8_BAR;
        PG8_STAGE(PG8_SB(1, 0), cB + kstep, voffB); PG8_STAGE(PG8_SA(1, 0), cA + kstep, voffA); PG8_STAGE(PG8_SB(1, 1), cB + hstep + kstep, voffB);
        PG8_WAIT_V(6); PG8_BAR;
    } else {
        PG8_STAGE(PG8_SB(0, 0), cB, voffB); PG8_STAGE(PG8_SA(0, 0), cA, voffA); PG8_STAGE(PG8_SB(0, 1), cB + hstep, voffB); PG8_STAGE(PG8_SA(0, 1), cA + hstep, voffA);
        if (wr == 1) PG8_BAR;
        PG8_WAIT_V(4); PG8_BAR;
        PG8_STAGE(PG8_SB(1, 0), cB + kstep, voffB); PG8_STAGE(PG8_SA(1, 0), cA + kstep, voffA); PG8_STAGE(PG8_SB(1, 1), cB + hstep + kstep, voffB);
        PG8_WAIT_V(6); PG8_BAR;
    }
    for (;;) {
        const bool has_next = S.next(ui + 1, nxt);
        const char* nA = has_next ? (const char*)g.A + (size_t)nxt.pm * tstep : cA; const char* nB = has_next ? (const char*)g.Bt + (size_t)nxt.pn * tstep : cB;
        for (int t = 0; t < nt; t += 2) {
            const bool last = (t == nt - 2);
            const char* a1 = cA + (size_t)(t + 1) * kstep;
            const char* a2 = last ? nA : cA + (size_t)(t + 2) * kstep; const char* b2 = last ? nB : cB + (size_t)(t + 2) * kstep;
            const char* a3 = a2 + kstep; const char* b3 = b2 + kstep;
            if constexpr (SP2) {
            PG8_LDB(B0, 0, 0); PG8_LDB(B1, 0, 1); PG8_SCHED; PG8_LDA(At, 0, 0); PG8_STAGE(PG8_SA(1, 1), a1 + hstep, voffA);
            PG8_WAIT_V(8); PG8_WAIT_L(0); PG8_BAR; PG8_MMA(0, 0, At, B0); PG8_MMA(0, 1, At, B1); PG8_BAR; PG8_SCHED;
            PG8_LDA(At, 0, 1); PG8_STAGE(PG8_SB(0, 0), b2, voffB); PG8_STAGE(PG8_SB(0, 1), b2 + hstep, voffB); PG8_STAGE(PG8_SA(0, 0), a2, voffA);
            PG8_WAIT_V(8); PG8_WAIT_L(0); PG8_BAR; PG8_MMA(1, 0, At, B0); PG8_MMA(1, 1, At, B1); PG8_BAR; PG8_SCHED;
            PG8_LDB(B0, 1, 0); PG8_LDB(B1, 1, 1); PG8_SCHED; PG8_LDA(At, 1, 0); PG8_STAGE(PG8_SA(0, 1), a2 + hstep, voffA);
            PG8_WAIT_V(8); PG8_WAIT_L(0); PG8_BAR; PG8_MMA(0, 0, At, B0); PG8_MMA(0, 1, At, B1); PG8_BAR; PG8_SCHED;
            PG8_LDA(At, 1, 1); PG8_STAGE(PG8_SB(1, 0), b3, voffB); PG8_STAGE(PG8_SB(1, 1), b3 + hstep, voffB); PG8_STAGE(PG8_SA(1, 0), a3, voffA);
            PG8_WAIT_V(8); PG8_WAIT_L(0); PG8_BAR; PG8_MMA(1, 0, At, B0); PG8_MMA(1, 1, At, B1); PG8_BAR; PG8_SCHED;
            } else {
            PG8_LDB(B0, 0, 0); PG8_SCHED; PG8_LDA(At, 0, 0); PG8_STAGE(PG8_SA(1, 1), a1 + hstep, voffA);
            PG8_WAIT_L(8); PG8_BAR; PG8_WAIT_L(0); PG8_MMA(0, 0, At, B0); PG8_BAR; PG8_SCHED;
            PG8_LDB(B1, 0, 1); PG8_STAGE(PG8_SB(0, 0), b2, voffB);
            PG8_BAR; PG8_WAIT_L(0); PG8_MMA(0, 1, At, B1); PG8_BAR;
            PG8_LDA(At, 0, 1); PG8_STAGE(PG8_SA(0, 0), a2, voffA);
            PG8_BAR; PG8_WAIT_L(0); PG8_MMA(1, 0, At, B0); PG8_BAR; PG8_SCHED;
            PG8_STAGE(PG8_SB(0, 1), b2 + hstep, voffB);
            PG8_WAIT_V(6); PG8_BAR; PG8_MMA(1, 1, At, B1); PG8_BAR;
            PG8_LDB(B0, 1, 0); PG8_SCHED; PG8_LDA(At, 1, 0); PG8_STAGE(PG8_SA(0, 1), a2 + hstep, voffA);
            PG8_WAIT_L(8); PG8_BAR; PG8_WAIT_L(0); PG8_MMA(0, 0, At, B0); PG8_BAR; PG8_SCHED;
            PG8_LDB(B1, 1, 1); PG8_STAGE(PG8_SB(1, 0), b3, voffB);
            PG8_BAR; PG8_WAIT_L(0); PG8_MMA(0, 1, At, B1); PG8_BAR;
            PG8_LDA(At, 1, 1); PG8_STAGE(PG8_SA(1, 0), a3, voffA);
            PG8_BAR; PG8_WAIT_L(0); PG8_MMA(1, 0, At, B0); PG8_BAR; PG8_SCHED;
            PG8_STAGE(PG8_SB(1, 1), b3 + hstep, voffB);
            PG8_WAIT_V(6); PG8_BAR; PG8_MMA(1, 1, At, B1); PG8_BAR;
                    }
        }
        if constexpr (ALIGN_EPI) { if (wr == 0) PG8_BAR; }
        if constexpr (!Epi::AFTER_DRAIN) { E(acc, cur, wr, wc, fr, fq); }
        if (!has_next) break;
#pragma unroll
        for (int a = 0; a < 2; ++a)
#pragma unroll
            for (int b = 0; b < 2; ++b)
#pragma unroll
                for (int m = 0; m < 4; ++m)
#pragma unroll
                    for (int n = 0; n < 2; ++n) acc[a][b][m][n] = (f32x4){0.f, 0.f, 0.f, 0.f};
        cur = nxt; cA = nA; cB = nB; ++ui;
        if constexpr (ALIGN_EPI) { if (wr == 1) PG8_BAR; }
    }
    PG8_WAIT_V(0);
    if constexpr (!ALIGN_EPI) { if (wr == 0) PG8_BAR; }
    PG8_BAR;
    if constexpr (Epi::AFTER_DRAIN) { E.fused(acc, cur, wr, wc, fr, fq, lds, wid, lane); }
#undef PG8_SA
#undef PG8_SB
#undef PG8_STAGE
#undef PG8_LDA
#undef PG8_LDB
#undef PG8_MMA
#undef PG8_WAIT_V
#undef PG8_WAIT_L
#undef PG8_BAR
#undef PG8_SCHED
}
}

DI int pi32(int r) { return (r & ~12) | ((r & 4) << 1) | ((r & 8) >> 1); }
struct KFrag { bf16x8 k[4]; };
struct VFrag { bf16x8 v[2][2]; };
DI void load_k(KFrag& f, const bf16_t* kbase) {
#pragma unroll
    for (int s = 0; s < 4; ++s) f.k[s] = *(const bf16x8*)(kbase + 16 * s);
}
DI void load_v(VFrag& f, const bf16_t* vbase, size_t vld) {
#pragma unroll
    for (int dt = 0; dt < 2; ++dt)
#pragma unroll
        for (int s = 0; s < 2; ++s) f.v[dt][s] = *(const bf16x8*)(vbase + (size_t)(32 * dt) * vld + 16 * s);
}
DI bf16x8 pack8(const f32x16& w, int s) {
    u32x4 p; p.x = pk_bf16(w[8 * s + 0], w[8 * s + 1]); p.y = pk_bf16(w[8 * s + 2], w[8 * s + 3]); p.z = pk_bf16(w[8 * s + 4], w[8 * s + 5]); p.w = pk_bf16(w[8 * s + 6], w[8 * s + 7]);
    return __builtin_bit_cast(bf16x8, p);
}
DI void pv_mma(const VFrag& f, const f32x16& w, f32x16& o0, f32x16& o1) {
#pragma unroll
    for (int s = 0; s < 2; ++s) { const bf16x8 pf = pack8(w, s); o0 = MFMA32(f.v[0][s], pf, o0); o1 = MFMA32(f.v[1][s], pf, o1); }
}
DI f32x16 qk_mma(const KFrag& f, const bf16x8 (&qf)[4]) {
    f32x16 st;
#pragma unroll
    for (int i = 0; i < 16; ++i) st[i] = 0.f;
#pragma unroll
    for (int s = 0; s < 4; ++s) st = MFMA32(f.k[s], qf[s], st);
    return st;
}

template <bool DIAG> DI void sb_tile(const KFrag& kf, const VFrag& vf, const bf16x8 (&qf)[4], float& F, f32x16& o0, f32x16& o1, int r, int hh) {
    const f32x16 st = qk_mma(kf, qf);
    f32x16 w; float M[2];
#pragma unroll
    for (int run = 0; run < 2; ++run) {
        float E = 1.f;
#pragma unroll
        for (int e = 7; e >= 0; --e) { const int i = 8 * run + e;
            const float ex = __builtin_amdgcn_exp2f(__builtin_fminf(st[i], 100.f));
            float sc = __builtin_amdgcn_rcpf(1.0f + ex), beta = ex * sc;
            if (DIAG) { if (e + 8 * hh + 16 * run >= r) { sc = 1.f; beta = 0.f; } }
            w[i] = beta * E; E *= sc; }
        M[run] = E;
    }
    const float P0 = __shfl_xor(M[0], 32), P1 = __shfl_xor(M[1], 32);
    const float off1 = F * (hh == 0 ? P1 : 1.f);
    const float off0 = F * (M[1] * P1) * (hh == 0 ? P0 : 1.f);
    F = F * (M[0] * P0) * (M[1] * P1);
#pragma unroll
    for (int i = 0; i < 16; ++i) w[i] *= (i < 8 ? off0 : off1);
    pv_mma(vf, w, o0, o1);
}
DI void mem_tile(const KFrag& kf, const VFrag& vf, const bf16x8 (&qf)[4], float& mx, float& lsum, f32x16& m0, f32x16& m1) {
    const f32x16 st = qk_mma(kf, qf);
    float tm = st[0];
#pragma unroll
    for (int i = 1; i < 16; ++i) tm = __builtin_fmaxf(tm, st[i]);
    tm = __builtin_fmaxf(tm, __shfl_xor(tm, 32));
    const float nm = __builtin_fmaxf(mx, tm), alpha = __builtin_amdgcn_exp2f(mx - nm); mx = nm;
    f32x16 w; float ps = 0.f;
#pragma unroll
    for (int i = 0; i < 16; ++i) { w[i] = __builtin_amdgcn_exp2f(st[i] - nm); ps += w[i]; }
    lsum = lsum * alpha + ps;
#pragma unroll
    for (int i = 0; i < 16; ++i) { m0[i] *= alpha; m1[i] *= alpha; }
    pv_mma(vf, w, m0, m1);
}
DI int gate_off(int tr, int ch) { return tr * 2048 + (ch >> 9) * 1024 + ((((ch & 511) >> 3) ^ (tr & 15)) << 4) + (ch & 7) * 2; }
DI void store_head(const f32x16& o0, const f32x16& o1, float rs, const unsigned char* gl, int tr, int ch0, const float* gs, bf16_t* yp) {
    u32x2 gt[8]; f32x4 gv[8];
#pragma unroll
    for (int q = 0; q < 8; ++q) { const int d = 32 * (q >> 2) + 8 * (q & 3); gt[q] = *(const u32x2*)(gl + gate_off(tr, ch0 + d)); gv[q] = *(const f32x4*)(gs + d); }
#pragma unroll
    for (int q = 0; q < 8; ++q) { const int d = 32 * (q >> 2) + 8 * (q & 3), g = q & 3;
        const f32x16& o = (q >> 2) ? o1 : o0;
        u32x2 w; w.x = pk_bf16(o[4 * g + 0] * rs * gv[q][0] * silu(bf_lo(gt[q].x)), o[4 * g + 1] * rs * gv[q][1] * silu(bf_hi(gt[q].x)));
        w.y = pk_bf16(o[4 * g + 2] * rs * gv[q][2] * silu(bf_lo(gt[q].y)), o[4 * g + 3] * rs * gv[q][3] * silu(bf_hi(gt[q].y)));
        *(u32x2*)(yp + d) = w; }
}
DI float ssq32(const f32x16& a, const f32x16& b) {
    float ss = 0.f;
#pragma unroll
    for (int i = 0; i < 16; ++i) ss += a[i] * a[i] + b[i] * b[i];
    return ss + __shfl_xor(ss, 32);
}
struct ConvW { f32x4 w0a, w0b, w1a, w1b, w2a, w2b, ba, bb; };
DI void conv_tok(const ConvW& cw, const bf16_t* RR, int t, int ch, float (&y)[8]) {
    const int t1 = t >= 1 ? t - 1 : 0, t2 = t >= 2 ? t - 2 : 0;
    const float k1 = t >= 1 ? 1.f : 0.f, k2 = t >= 2 ? 1.f : 0.f;
    const bf16_t* rp0 = RR + (size_t)t * 2048 + ch; const bf16_t* rp1 = RR + (size_t)t1 * 2048 + ch; const bf16_t* rp2 = RR + (size_t)t2 * 2048 + ch;
    const u32x4 u0 = *(const u32x4*)rp0, b0 = *(const u32x4*)(rp0 + 256), c0 = *(const u32x4*)(rp0 + 512);
    const u32x4 u1 = *(const u32x4*)rp1, c1 = *(const u32x4*)(rp1 + 512), u2 = *(const u32x4*)rp2, c2 = *(const u32x4*)(rp2 + 512);
#pragma unroll
    for (int e2 = 0; e2 < 4; ++e2) {
        const int j = (2 * e2) & 3;
        const f32x4& w0 = e2 < 2 ? cw.w0a : cw.w0b; const f32x4& w1 = e2 < 2 ? cw.w1a : cw.w1b; const f32x4& w2 = e2 < 2 ? cw.w2a : cw.w2b; const f32x4& bb = e2 < 2 ? cw.ba : cw.bb;
        y[2 * e2] = bf_lo(b0[e2]) * (w0[j] * (k2 * bf_lo(u2[e2]) * bf_lo(c2[e2])) + w1[j] * (k1 * bf_lo(u1[e2]) * bf_lo(c1[e2])) + w2[j] * (bf_lo(u0[e2]) * bf_lo(c0[e2])) + bb[j]);
        y[2 * e2 + 1] = bf_hi(b0[e2]) * (w0[j + 1] * (k2 * bf_hi(u2[e2]) * bf_hi(c2[e2])) + w1[j + 1] * (k1 * bf_hi(u1[e2]) * bf_hi(c1[e2])) + w2[j + 1] * (bf_hi(u0[e2]) * bf_hi(c0[e2])) + bb[j + 1]);
    }
}
#define ZERO16(v) do { _Pragma("unroll") for (int _i = 0; _i < 16; ++_i) (v)[_i] = 0.f; } while (0)

DI void mixer_phase(const Params& p, unsigned char* ldsraw, int vid) {
    float* lf = (float*)ldsraw;
    int tid = threadIdx.x; asm volatile("" : "+v"(tid));
    const int wid = __builtin_amdgcn_readfirstlane(tid >> 6), lane = tid & 63;
    const bf16_t* QK = (const bf16_t*)(p.ws + WS_QK);
    const bf16_t* VT = (const bf16_t*)(p.ws + WS_VT);
    const bf16_t* RR = (const bf16_t*)(p.ws + WS_R);
    const bf16_t* MK = (const bf16_t*)(p.ws + WS_MK);
    const bf16_t* MVT = (const bf16_t*)(p.ws + WS_MVT);
    bf16_t* Y = (bf16_t*)(p.ws + WS_Y);
    for (int it = vid; it < T / 64; it += gridDim.x) {
        const int item = ((it & 7) << 5) | (it >> 3);
        int ln = lane; asm volatile("" : "+v"(ln));
        const int r = ln & 31, hh = ln >> 5, pr = pi32(r);
        const int t0 = item * 64, tqA = t0 + r, tqB = tqA + 32;
        {
#pragma unroll 4
            for (int j = 0; j < 16; ++j) { const int q = wid * 16 + j, tr = q >> 1, half = q & 1;
                __builtin_amdgcn_global_load_lds((const unsigned*)(RR + (size_t)(t0 + tr) * 2048 + 1024 + half * 512 + ((ln ^ (tr & 15)) << 3)), (LAS unsigned*)((LAS unsigned char*)ldsraw + 4096 + tr * 2048 + half * 1024), 16, 0, 0); }
        }
        const unsigned char* gl = ldsraw + 4096;
        {
            f32x16 oA0, oA1, oB0, oB1; ZERO16(oA0); ZERO16(oA1); ZERO16(oB0); ZERO16(oB1);
            bf16x8 qfA[4], qfB[4];
            { const bf16_t* qp = QK + (size_t)tqA * 1024 + 64 * wid + 8 * hh;
#pragma unroll
              for (int s = 0; s < 4; ++s) { qfA[s] = *(const bf16x8*)(qp + 16 * s); qfB[s] = *(const bf16x8*)(qp + 32 * 1024 + 16 * s); } }
            const bf16_t* kb = QK + (size_t)pr * 1024 + 512 + 64 * wid + 8 * hh;
            const bf16_t* vb = VT + (size_t)(64 * wid + r) * T + 8 * hh;
            float FA = 1.f, FB = 1.f;
            KFrag kc, kn; VFrag vc, vn;
            load_k(kc, kb + (size_t)(t0 + 32) * 1024); load_v(vc, vb + t0 + 32, T); load_k(kn, kb + (size_t)t0 * 1024); load_v(vn, vb + t0, T);
            sb_tile<true>(kc, vc, qfB, FB, oB0, oB1, r, hh);
            kc = kn; vc = vn;
            int key0 = t0 - 32;
            if (key0 >= 0) { load_k(kn, kb + (size_t)key0 * 1024); load_v(vn, vb + key0, T); }
            sb_tile<true>(kc, vc, qfA, FA, oA0, oA1, r, hh);
            sb_tile<false>(kc, vc, qfB, FB, oB0, oB1, r, hh);
#pragma unroll 1
            while (key0 >= 0) {
                const bool actA = __builtin_amdgcn_ballot_w64(FA >= SB_STOP_F) != 0ull, actB = __builtin_amdgcn_ballot_w64(FB >= SB_STOP_F) != 0ull;
                if (!actA && !actB) break;
                kc = kn; vc = vn;
                if (key0 >= 32) { load_k(kn, kb + (size_t)(key0 - 32) * 1024); load_v(vn, vb + key0 - 32, T); }
                if (actA) sb_tile<false>(kc, vc, qfA, FA, oA0, oA1, r, hh);
                if (actB) sb_tile<false>(kc, vc, qfB, FB, oB0, oB1, r, hh);
                key0 -= 32;
            }
            const float sA = ssq32(oA0, oA1), sB = ssq32(oB0, oB1);
            if (hh == 0) { lf[wid * 32 + r] = sA; lf[256 + wid * 32 + r] = sB; }
            asm volatile("s_waitcnt vmcnt(0)" ::: "memory");
            __syncthreads();
            float totA = 0.f, totB = 0.f;
#pragma unroll
            for (int w8 = 0; w8 < 8; ++w8) { totA += lf[w8 * 32 + r]; totB += lf[256 + w8 * 32 + r]; }
            const float* gs = p.g_sb + 64 * wid + 4 * hh;
            store_head(oA0, oA1, rsqrtf(totA * (1.0f / 512.0f) + EPS), gl, r, 64 * wid + 4 * hh, gs, Y + (size_t)tqA * 1024 + 64 * wid + 4 * hh);
            store_head(oB0, oB1, rsqrtf(totB * (1.0f / 512.0f) + EPS), gl, r + 32, 64 * wid + 4 * hh, gs, Y + (size_t)tqB * 1024 + 64 * wid + 4 * hh);
        }
        {
            f32x16 a0, a1, b0, b1; ZERO16(a0); ZERO16(a1); ZERO16(b0); ZERO16(b1);
            if (wid < 4) {
                bf16x8 qfA[4], qfB[4];
                { const bf16_t* qp = RR + (size_t)tqA * 2048 + 768 + 64 * wid + 8 * hh;
#pragma unroll
                  for (int s = 0; s < 4; ++s) { qfA[s] = *(const bf16x8*)(qp + 16 * s); qfB[s] = *(const bf16x8*)(qp + 32 * 2048 + 16 * s); } }
                const bf16_t* kb = MK + (size_t)pr * 256 + 64 * wid + 8 * hh;
                const bf16_t* vb = MVT + (size_t)(64 * wid + r) * 256 + 8 * hh;
                float mxA = -1e30f, lsA = 0.f, mxB = -1e30f, lsB = 0.f;
                KFrag kc, kn; VFrag vc, vn;
                load_k(kc, kb); load_v(vc, vb, 256);
#pragma unroll 1
                for (int mt = 0; mt < 8; ++mt) {
                    const int nx = mt < 7 ? mt + 1 : 7;
                    load_k(kn, kb + (size_t)(32 * nx) * 256); load_v(vn, vb + 32 * nx, 256);
                    mem_tile(kc, vc, qfA, mxA, lsA, a0, a1);
                    mem_tile(kc, vc, qfB, mxB, lsB, b0, b1);
                    kc = kn; vc = vn;
                }
                lsA += __shfl_xor(lsA, 32); lsB += __shfl_xor(lsB, 32);
                const float iA = 1.0f / lsA, iB = 1.0f / lsB;
#pragma unroll
                for (int i = 0; i < 16; ++i) { a0[i] *= iA; a1[i] *= iA; b0[i] *= iB; b1[i] *= iB; }
                const float sA = ssq32(a0, a1), sB = ssq32(b0, b1);
                if (hh == 0) { lf[512 + wid * 32 + r] = sA; lf[640 + wid * 32 + r] = sB; }
            } else {
                const int cgp = wid - 4, chunk = ln & 7, trow = ln >> 3, ch = 64 * cgp + 8 * chunk;
                ConvW cw; { const float* wp = p.conv_w + ch; const float* bp = p.conv_b + ch;
                    cw.w0a = *(const f32x4*)wp; cw.w0b = *(const f32x4*)(wp + 4); cw.w1a = *(const f32x4*)(wp + 256); cw.w1b = *(const f32x4*)(wp + 260);
                    cw.w2a = *(const f32x4*)(wp + 512); cw.w2b = *(const f32x4*)(wp + 516); cw.ba = *(const f32x4*)bp; cw.bb = *(const f32x4*)(bp + 4); }
#pragma unroll
                for (int j = 0; j < 8; ++j) {
                    float y[8]; conv_tok(cw, RR, t0 + trow + 8 * j, ch, y);
                    float ss = 0.f;
#pragma unroll
                    for (int e = 0; e < 8; ++e) ss += y[e] * y[e];
                    ss += __shfl_xor(ss, 1); ss += __shfl_xor(ss, 2); ss += __shfl_xor(ss, 4);
                    const int tk = trow + 8 * j;
                    if (chunk == 0) lf[768 + 128 * (tk >> 5) + cgp * 32 + (tk & 31)] = ss;
                    f32x16& dst = (j < 2) ? a0 : (j < 4) ? a1 : (j < 6) ? b0 : b1;
#pragma unroll
                    for (int e = 0; e < 8; ++e) dst[(j & 1) * 8 + e] = y[e];
                    if ((j & 3) == 3) __builtin_amdgcn_sched_barrier(0);
                }
            }
            __syncthreads();
            if (wid < 4) {
                const float totA = (lf[512 + r] + lf[544 + r]) + (lf[576 + r] + lf[608 + r]), totB = (lf[640 + r] + lf[672 + r]) + (lf[704 + r] + lf[736 + r]);
                const float* gs = p.g_memo + 64 * wid + 4 * hh;
                store_head(a0, a1, rsqrtf(totA * (1.0f / 256.0f) + EPS), gl, r, 768 + 64 * wid + 4 * hh, gs, Y + (size_t)tqA * 1024 + 768 + 64 * wid + 4 * hh);
                store_head(b0, b1, rsqrtf(totB * (1.0f / 256.0f) + EPS), gl, r + 32, 768 + 64 * wid + 4 * hh, gs, Y + (size_t)tqB * 1024 + 768 + 64 * wid + 4 * hh);
            } else {
                const int cgp = wid - 4, chunk = ln & 7, trow = ln >> 3, ch = 64 * cgp + 8 * chunk;
                const f32x4 ga = *(const f32x4*)(p.g_conv + ch), gb = *(const f32x4*)(p.g_conv + ch + 4);
                u32x4 gt[8]; float rsv[8];
#pragma unroll
                for (int j = 0; j < 8; ++j) { const int tk = trow + 8 * j; const float* lp = lf + 768 + 128 * (tk >> 5) + (tk & 31);
                    rsv[j] = rsqrtf(((lp[0] + lp[32]) + (lp[64] + lp[96])) * (1.0f / 256.0f) + EPS);
                    gt[j] = *(const u32x4*)(gl + gate_off(tk, 512 + ch)); }
#pragma unroll
                for (int j = 0; j < 8; ++j) { const int tk = trow + 8 * j;
                    const f32x16& o = (j < 2) ? a0 : (j < 4) ? a1 : (j < 6) ? b0 : b1; const int b8 = (j & 1) * 8; const float rs = rsv[j];
                    u32x4 w; w.x = pk_bf16(o[b8 + 0] * rs * ga[0] * silu(bf_lo(gt[j].x)), o[b8 + 1] * rs * ga[1] * silu(bf_hi(gt[j].x)));
                    w.y = pk_bf16(o[b8 + 2] * rs * ga[2] * silu(bf_lo(gt[j].y)), o[b8 + 3] * rs * ga[3] * silu(bf_hi(gt[j].y)));
                    w.z = pk_bf16(o[b8 + 4] * rs * gb[0] * silu(bf_lo(gt[j].z)), o[b8 + 5] * rs * gb[1] * silu(bf_hi(gt[j].z)));
                    w.w = pk_bf16(o[b8 + 6] * rs * gb[2] * silu(bf_lo(gt[j].w)), o[b8 + 7] * rs * gb[3] * silu(bf_hi(gt[j].w)));
                    *(u32x4*)(Y + (size_t)(t0 + tk) * 1024 + 512 + ch) = w; }
            }
        }
        __syncthreads();
    }
}

DI void finalnorm_phase(const Params& p) {
    const float* ssq = (const float*)(p.ws + WS_SSQ);
    const int wid = threadIdx.x >> 6, lane = threadIdx.x & 63;
    for (int row = blockIdx.x * 8 + wid; row < T; row += gridDim.x * 8) {
        const float tot = (ssq[row] + ssq[T + row]) + (ssq[2 * T + row] + ssq[3 * T + row]);
        const float rs = rsqrtf(tot * (1.0f / 1024.0f) + EPS);
        float* o = p.out + (size_t)row * D;
#pragma unroll
        for (int j = 0; j < 4; ++j) { f32x4 v = *(f32x4*)(o + 256 * j + 4 * lane); const f32x4 g = *(const f32x4*)(p.g_final + 256 * j + 4 * lane); *(f32x4*)(o + 256 * j + 4 * lane) = v * rs * g; }
    }
}

template <class Hook> DI void xcc_local_barrier(const XcdBarrier& b, unsigned* lb, const Hook& hook) {
    asm volatile("s_waitcnt vmcnt(0)" ::: "memory");
    __syncthreads();
    if (threadIdx.x >= 64) hook();
    unsigned wait = 0u;
    if (threadIdx.x == 0) {
        __builtin_amdgcn_s_waitcnt(0);
        const unsigned nloc = b.st[0];
        const unsigned old = xb_add(&lb[64 * b.x], 1u);
        if (old + 1u == nloc) xb_add(&lb[64 * (16 + b.x)], 1u); else wait = 1u;
    }
    if (threadIdx.x < 64) hook();
    if (threadIdx.x == 0) {
        if (wait) XB_SPIN(xb_ld(&lb[64 * (16 + b.x)]) == 0u, b.bar);
        __builtin_amdgcn_fence(__ATOMIC_ACQUIRE, "agent");
        asm volatile("s_waitcnt vmcnt(0)" ::: "memory");
    }
    __syncthreads();
}
#define ZERO_ACC(acc) do { _Pragma("unroll") for (int _a = 0; _a < 2; ++_a) _Pragma("unroll") for (int _b = 0; _b < 2; ++_b) _Pragma("unroll") for (int _m = 0; _m < 4; ++_m) _Pragma("unroll") for (int _n = 0; _n < 2; ++_n) \
    (acc)[_a][_b][_m][_n] = (f32x4){0.f, 0.f, 0.f, 0.f}; } while (0)
template <int PH> __global__ void __launch_bounds__(512, 2) fwd(Params p) {
    extern __shared__ __attribute__((aligned(16))) unsigned char lds[];
    XcdBarrier xb{};
    if (PH < 0) {
        if (p.ws == nullptr) cg::this_grid().sync();
        volatile LAS unsigned* st = (volatile LAS unsigned*)((LAS unsigned char*)lds + LDS_MAIN);
        if (threadIdx.x == 0) { st[0] = 0u; st[1] = 0u; st[2] = 0u; st[3] = 0u; }
        __syncthreads();
        xb = xcd_barrier_post((unsigned*)(p.ws + WS_BAR), st);
    }
    if (PH < 0 || PH == 0) prep_phase(p, lds);
#if PROBE_DUP == 0
    if (PH < 0) { xcd_barrier(xb); prep_phase(p, lds); }
#endif
    if (PH < 0) xcd_barrier(xb);
    int vid = blockIdx.x; bool even = false;
    if (PH < 0) { volatile LAS unsigned* st = (volatile LAS unsigned*)((LAS unsigned char*)lds + LDS_MAIN); even = st[2] != 0u; if (even) vid = (int)(xb.x + 8u * st[3]); }
    if (PH < 0 || PH == 1) {
        pg8::Gemm g; g.A = (const bf16_t*)(p.ws + WS_OPS); g.Bt = g.A; g.K = 1024;
        pg8::ProjOrder S; S.G = gridDim.x; S.c = vid;
        pg8::EpiProj E; E.qk = (bf16_t*)(p.ws + WS_QK); E.vt = (bf16_t*)(p.ws + WS_VT); E.r = (bf16_t*)(p.ws + WS_R); E.mk = (bf16_t*)(p.ws + WS_MK); E.mvt = (bf16_t*)(p.ws + WS_MVT);
        f32x4 acc[2][2][4][2]; ZERO_ACC(acc);
        pg8::gemm_phase<pg8::EpiProj, pg8::ProjOrder, true>((LAS unsigned char*)lds, g, S, E, acc);
    }
    if (PH < 0) xcd_barrier(xb);
    if (PH < 0 || PH == 2) mixer_phase(p, lds, vid);
#if PROBE_DUP == 2
    if (PH < 0) { xcd_barrier(xb); mixer_phase(p, lds, vid); }
#endif
    if (PH < 0 || PH == 3) {
        pg8::Gemm g; g.A = (const bf16_t*)(p.ws + WS_Y); g.Bt = (const bf16_t*)(p.ws + WS_WOUT); g.K = 1024;
        pg8::OutOrder S; S.G = gridDim.x; S.c = vid;
        pg8::EpiFinal<(PH < 0)> E; E.x = p.x; E.gf = p.g_final; E.out = p.out; E.ssq = (float*)(p.ws + WS_SSQ); E.xb = xb; E.pcnt = (unsigned*)(p.ws + WS_PCNT);
        f32x4 acc[2][2][4][2];
        pg8::Unit u0; const bool has = S.next(0, u0);
        int tid = threadIdx.x; asm volatile("" : "+v"(tid));
        auto hook = [&]() { if (has) E.load_x(acc, u0, tid); };
        if (PH < 0) { if (even) xcc_local_barrier(xb, (unsigned*)(p.ws + WS_LBAR), hook); else xcd_barrier(xb, hook); } else hook();
        pg8::gemm_phase<pg8::EpiFinal<(PH < 0)>, pg8::OutOrder>((LAS unsigned char*)lds, g, S, E, acc);
    }
    if (PH == 4) finalnorm_phase(p);
}

extern "C" void kernel_launch(void* const* d_in, const int* in_sizes, int n_in, void* d_out, int out_size, void* d_ws, size_t ws_size, hipStream_t stream) {
    constexpr int LDS_BYTES = LDS_MAIN + 16;
    static int ready = 0;
    if (!ready) {
        if (n_in != 13 || ws_size < WS_END) { fprintf(stderr, "kernel_launch: unexpected inputs (n_in %d, ws %zu < %zu)\n", n_in, ws_size, (size_t)WS_END); ready = -1; return; }
        (void)hipFuncSetAttribute((const void*)fwd<-1>, hipFuncAttributeMaxDynamicSharedMemorySize, LDS_BYTES);
        (void)hipFuncSetAttribute((const void*)fwd<0>, hipFuncAttributeMaxDynamicSharedMemorySize, LDS_BYTES);
        (void)hipFuncSetAttribute((const void*)fwd<1>, hipFuncAttributeMaxDynamicSharedMemorySize, LDS_BYTES);
        (void)hipFuncSetAttribute((const void*)fwd<2>, hipFuncAttributeMaxDynamicSharedMemorySize, LDS_BYTES);
        (void)hipFuncSetAttribute((const void*)fwd<3>, hipFuncAttributeMaxDynamicSharedMemorySize, LDS_BYTES);
        (void)hipFuncSetAttribute((const void*)fwd<4>, hipFuncAttributeMaxDynamicSharedMemorySize, LDS_BYTES);
        ready = 1;
    }
    if (ready < 0) return;
    Params p{};
    p.x = (const float*)d_in[0]; p.mem = (const float*)d_in[1]; p.g_in = (const float*)d_in[2]; p.w_in = (const float*)d_in[3]; p.conv_w = (const float*)d_in[4];
    p.conv_b = (const float*)d_in[5]; p.g_mem = (const float*)d_in[6]; p.w_kv = (const float*)d_in[7]; p.g_sb = (const float*)d_in[8]; p.g_conv = (const float*)d_in[9];
    p.g_memo = (const float*)d_in[10]; p.w_out = (const float*)d_in[11]; p.g_final = (const float*)d_in[12];
    p.out = (float*)d_out; p.ws = (unsigned char*)d_ws;
    const int grid = 256;
#if COOP
    (void)hipMemsetAsync((unsigned char*)d_ws + WS_BAR, 0, (size_t)XCD_BAR_WORDS * 4 + (size_t)64 * 256 + (size_t)32 * 256, stream);
    void* args[] = {&p};
    hipError_t e = hipLaunchCooperativeKernel((const void*)fwd<-1>, dim3(grid), dim3(512), args, LDS_BYTES, stream);
    if (e != hipSuccess) fprintf(stderr, "cooperative launch failed: %s\n", hipGetErrorString(e));
#else
    hipLaunchKernelGGL(fwd<0>, dim3(grid), dim3(512), LDS_BYTES, stream, p);
    hipLaunchKernelGGL(fwd<1>, dim3(grid), dim3(512), LDS_BYTES, stream, p);
    hipLaunchKernelGGL(fwd<2>, dim3(grid), dim3(512), LDS_BYTES, stream, p);
    hipLaunchKernelGGL(fwd<3>, dim3(grid), dim3(512), LDS_BYTES, stream, p);
    hipLaunchKernelGGL(fwd<4>, dim3(grid), dim3(512), LDS_BYTES, stream, p);
#endif
}
```
